# Optimizing an MI355X kernel written in HIP

```python
import jax
import jax.numpy as jnp
from jax import lax
import numpy as np


D_MODEL = 2048
BATCH = 4
SEQ = 4096
DEPTH = 1

MEM_LEN = 256
BLOCK = 128
EPS = 1e-6
NEG_INF = -1e30

SWA_Q_HEADS = 16
SWA_KV_HEADS = 2
SWA_HEAD_DIM = 64
WINDOW = 128

MLA_HEADS = 4
MLA_Q_RANK = 512
MLA_KV_RANK = 512
MLA_NOPE_DIM = 128
MLA_ROPE_DIM = 64
MLA_V_DIM = 128
ROPE_THETA = 10000.0

MEM_HEADS = 4
MEM_HEAD_DIM = 128

MIX_WIDTH = SWA_Q_HEADS * SWA_HEAD_DIM + MLA_HEADS * MLA_V_DIM + MEM_HEADS * MEM_HEAD_DIM
IN_SIZES = (SWA_Q_HEADS * SWA_HEAD_DIM, SWA_KV_HEADS * SWA_HEAD_DIM, SWA_KV_HEADS * SWA_HEAD_DIM,
            MLA_Q_RANK, MLA_KV_RANK, MLA_ROPE_DIM, MEM_HEADS * MEM_HEAD_DIM)
IN_WIDTH = sum(IN_SIZES)
IN_SPLITS = tuple(int(v) for v in np.cumsum(IN_SIZES)[:-1])

D_FF = ((8 * D_MODEL + 3 * 256 - 1) // (3 * 256)) * 256

kernel_name = "hymba_swa_sink_mla_memory_swiglu"


def rms_norm(x, g):
    xf = x.astype(jnp.float32)
    y = xf * lax.rsqrt(jnp.mean(xf * xf, axis=-1, keepdims=True) + EPS)
    return (y * g.astype(jnp.float32)).astype(x.dtype)


def alibi_slopes(n):
    return 2.0 ** (-8.0 * jnp.arange(1, n + 1, dtype=jnp.float32) / n)


def apply_rope(x, cos, sin):
    x1, x2 = jnp.split(x.astype(jnp.float32), 2, axis=-1)
    return jnp.concatenate([x1 * cos - x2 * sin, x1 * sin + x2 * cos], axis=-1).astype(x.dtype)


def swa_sink_attention(q, k, v, pos, sinks):
    b, s, _, d = q.shape
    nb = s // BLOCK
    g = SWA_Q_HEADS // SWA_KV_HEADS
    qb = q.reshape(b, nb, BLOCK, SWA_KV_HEADS, g, d)

    def with_prev(t):
        tb = t.reshape((b, nb, BLOCK) + t.shape[2:])
        prev = jnp.concatenate([jnp.zeros_like(tb[:, :1]), tb[:, :-1]], axis=1)
        return jnp.concatenate([prev, tb], axis=2)

    kb, vb, pk = with_prev(k), with_prev(v), with_prev(pos)
    pq = pos.reshape(b, nb, BLOCK)
    scores = jnp.einsum('bnqhgd,bnkhd->bnhgqk', qb, kb,
                        preferred_element_type=jnp.float32) * (d ** -0.5)
    dist = jnp.abs(pq[:, :, :, None] - pk[:, :, None, :]).astype(jnp.float32)
    slopes = alibi_slopes(SWA_Q_HEADS).reshape(SWA_KV_HEADS, g)
    scores = scores - slopes[None, None, :, :, None, None] * dist[:, :, None, None]
    qi = jnp.arange(BLOCK)[:, None] + BLOCK
    ki = jnp.arange(2 * BLOCK)[None, :]
    band = (ki <= qi) & (qi - ki < WINDOW)
    not_first = jnp.arange(nb)[:, None, None] > 0
    valid = band[None] & (not_first | (ki >= BLOCK)[None])
    scores = jnp.where(valid[None, :, None, None], scores, NEG_INF)
    sink = sinks.astype(jnp.float32).reshape(SWA_KV_HEADS, g)[None, None, :, :, None, None]
    m = jnp.maximum(jnp.max(scores, axis=-1, keepdims=True), sink)
    p = jnp.exp(scores - m)
    p = p / (jnp.sum(p, axis=-1, keepdims=True) + jnp.exp(sink - m))
    out = jnp.einsum('bnhgqk,bnkhd->bnqhgd', p.astype(v.dtype), vb)
    return out.reshape(b, s, SWA_Q_HEADS * d)


def mla_causal_attention(q_nope, q_rope, k_nope, k_rope, v):
    b, s, h, _ = q_nope.shape
    nb = s // BLOCK
    scale = (MLA_NOPE_DIM + MLA_ROPE_DIM) ** -0.5
    k_idx = jnp.arange(s)

    def to_blocks(t):
        return jnp.moveaxis(t.reshape((b, nb, BLOCK) + t.shape[2:]), 1, 0)

    def one_block(args):
        qn, qr, i = args
        sc = (jnp.einsum('bqhd,bkhd->bhqk', qn, k_nope, preferred_element_type=jnp.float32)
              + jnp.einsum('bqhd,bkd->bhqk', qr, k_rope, preferred_element_type=jnp.float32)) * scale
        q_idx = i * BLOCK + jnp.arange(BLOCK)
        sc = jnp.where(k_idx[None, :] <= q_idx[:, None], sc, NEG_INF)
        p = jax.nn.softmax(sc, axis=-1).astype(v.dtype)
        return jnp.einsum('bhqk,bkhd->bqhd', p, v)

    out = lax.map(one_block, (to_blocks(q_nope), to_blocks(q_rope), jnp.arange(nb)))
    return jnp.moveaxis(out, 0, 1).reshape(b, s, h * MLA_V_DIM)


def memory_cross_attention(q, k, v):
    b, s, h, d = q.shape
    sc = jnp.einsum('bshd,bmhd->bhsm', q, k, preferred_element_type=jnp.float32) * (d ** -0.5)
    p = jax.nn.softmax(sc, axis=-1).astype(v.dtype)
    return jnp.einsum('bhsm,bmhd->bshd', p, v).reshape(b, s, h * d)


def setup_inputs(seed: int = 0) -> dict:
    key = jax.random.key(seed)
    ks = iter(jax.random.split(key, 32))

    def nrm(shape, fan_in):
        return jax.random.normal(next(ks), shape, jnp.float32) * (fan_in ** -0.5)

    def gain(n):
        return 1.0 + 0.02 * jax.random.normal(next(ks), (DEPTH, n), jnp.float32)

    x = jax.random.normal(next(ks), (BATCH, SEQ, D_MODEL), jnp.float32)
    mem = jax.random.normal(next(ks), (BATCH, MEM_LEN, D_MODEL), jnp.float32)
    offsets = jax.random.randint(next(ks), (BATCH, 1), 0, 1024, dtype=jnp.int32)
    positions = offsets + jnp.arange(SEQ, dtype=jnp.int32)[None, :]
    return {
        "x": x,
        "mem": mem,
        "positions": positions,
        "attn_norm_g": gain(D_MODEL),
        "w_in": nrm((DEPTH, D_MODEL, IN_WIDTH), D_MODEL),
        "swa_q_norm_g": gain(SWA_HEAD_DIM),
        "swa_k_norm_g": gain(SWA_HEAD_DIM),
        "swa_sinks": 0.5 * jax.random.normal(next(ks), (DEPTH, SWA_Q_HEADS), jnp.float32),
        "mla_cq_norm_g": gain(MLA_Q_RANK),
        "mla_ckv_norm_g": gain(MLA_KV_RANK),
        "w_uq": nrm((DEPTH, MLA_Q_RANK, MLA_HEADS * (MLA_NOPE_DIM + MLA_ROPE_DIM)), MLA_Q_RANK),
        "w_ukv": nrm((DEPTH, MLA_KV_RANK, MLA_HEADS * (MLA_NOPE_DIM + MLA_V_DIM)), MLA_KV_RANK),
        "mla_qn_norm_g": gain(MLA_NOPE_DIM),
        "mla_qr_norm_g": gain(MLA_ROPE_DIM),
        "mla_kn_norm_g": gain(MLA_NOPE_DIM),
        "mla_kr_norm_g": gain(MLA_ROPE_DIM),
        "mem_norm_g": gain(D_MODEL),
        "w_mem_kv": nrm((DEPTH, D_MODEL, 2 * MEM_HEADS * MEM_HEAD_DIM), D_MODEL),
        "mem_q_norm_g": gain(MEM_HEAD_DIM),
        "mem_k_norm_g": gain(MEM_HEAD_DIM),
        "w_out": nrm((DEPTH, MIX_WIDTH, D_MODEL), MIX_WIDTH),
        "ffn_norm_g": gain(D_MODEL),
        "w_gate": nrm((DEPTH, D_MODEL, D_FF), D_MODEL),
        "w_up": nrm((DEPTH, D_MODEL, D_FF), D_MODEL),
        "w_down": nrm((DEPTH, D_FF, D_MODEL), D_FF),
    }


def reference(x, mem, positions, attn_norm_g, w_in, swa_q_norm_g, swa_k_norm_g, swa_sinks,
              mla_cq_norm_g, mla_ckv_norm_g, w_uq, w_ukv, mla_qn_norm_g, mla_qr_norm_g,
              mla_kn_norm_g, mla_kr_norm_g, mem_norm_g, w_mem_kv, mem_q_norm_g, mem_k_norm_g,
              w_out, ffn_norm_g, w_gate, w_up, w_down):
    b, s, _ = x.shape
    m_len = mem.shape[1]
    inv_freq = ROPE_THETA ** (-jnp.arange(0, MLA_ROPE_DIM, 2, dtype=jnp.float32) / MLA_ROPE_DIM)
    ang = positions.astype(jnp.float32)[..., None] * inv_freq
    cos, sin = jnp.cos(ang), jnp.sin(ang)
    h = x
    for l in range(DEPTH):
        hn = rms_norm(h, attn_norm_g[l])
        proj = hn @ w_in[l]
        q_a, k_a, v_a, c_q, c_kv, k_r, q_m = jnp.split(proj, IN_SPLITS, axis=-1)

        q_a = rms_norm(q_a.reshape(b, s, SWA_Q_HEADS, SWA_HEAD_DIM), swa_q_norm_g[l])
        k_a = rms_norm(k_a.reshape(b, s, SWA_KV_HEADS, SWA_HEAD_DIM), swa_k_norm_g[l])
        v_a = v_a.reshape(b, s, SWA_KV_HEADS, SWA_HEAD_DIM)
        y_a = swa_sink_attention(q_a, k_a, v_a, positions, swa_sinks[l])

        q_b = (rms_norm(c_q, mla_cq_norm_g[l]) @ w_uq[l]).reshape(
            b, s, MLA_HEADS, MLA_NOPE_DIM + MLA_ROPE_DIM)
        kv_b = (rms_norm(c_kv, mla_ckv_norm_g[l]) @ w_ukv[l]).reshape(
            b, s, MLA_HEADS, MLA_NOPE_DIM + MLA_V_DIM)
        q_nope = rms_norm(q_b[..., :MLA_NOPE_DIM], mla_qn_norm_g[l])
        q_rope = apply_rope(rms_norm(q_b[..., MLA_NOPE_DIM:], mla_qr_norm_g[l]),
                            cos[:, :, None], sin[:, :, None])
        k_nope = rms_norm(kv_b[..., :MLA_NOPE_DIM], mla_kn_norm_g[l])
        v_b = kv_b[..., MLA_NOPE_DIM:]
        k_rope = apply_rope(rms_norm(k_r, mla_kr_norm_g[l]), cos, sin)
        y_b = mla_causal_attention(q_nope, q_rope, k_nope, k_rope, v_b)

        q_m = rms_norm(q_m.reshape(b, s, MEM_HEADS, MEM_HEAD_DIM), mem_q_norm_g[l])
        kv_m = (rms_norm(mem, mem_norm_g[l]) @ w_mem_kv[l]).reshape(
            b, m_len, 2, MEM_HEADS, MEM_HEAD_DIM)
        k_m = rms_norm(kv_m[:, :, 0], mem_k_norm_g[l])
        v_m = kv_m[:, :, 1]
        y_m = memory_cross_attention(q_m, k_m, v_m)

        h = h + jnp.concatenate([y_a, y_b, y_m], axis=-1) @ w_out[l]

        fn = rms_norm(h, ffn_norm_g[l])
        h = h + (jax.nn.silu(fn @ w_gate[l]) * (fn @ w_up[l])) @ w_down[l]
    return h
```

```cpp
#include <hip/hip_runtime.h>
#include <hip/hip_cooperative_groups.h>
#include <cstdio>
#include <cstdint>
namespace cg = cooperative_groups;

#ifndef N_LAUNCHES
#define N_LAUNCHES 1
#endif

#define LAS __attribute__((address_space(3)))
typedef unsigned short bf16_t;
typedef short bf16x8 __attribute__((ext_vector_type(8)));
typedef short s16x4 __attribute__((ext_vector_type(4)));
typedef float f32x4 __attribute__((ext_vector_type(4)));
typedef float f32x16 __attribute__((ext_vector_type(16)));
typedef unsigned u32x4 __attribute__((ext_vector_type(4)));
typedef unsigned u32x2 __attribute__((ext_vector_type(2)));
typedef float f32x2_t __attribute__((ext_vector_type(2)));
typedef __bf16 bf16x2_t __attribute__((ext_vector_type(2)));

constexpr int BATCH = 4, SEQ = 4096, MTOK = BATCH * SEQ, DM = 2048, MEML = 256, MMEM = BATCH * MEML;
constexpr int INW = 2880, INP = 3072, DFF = 5632;
constexpr int C_QA = 0, C_KA = 1024, C_VA = 1152, C_CQ = 1280, C_CKV = 1792, C_KR = 2304, C_QM = 2368;
constexpr int NQKV = 1792;
constexpr float EPS = 1e-6f;
constexpr float LOG2E = 1.4426950408889634f;
constexpr float QS_SWA = 0.125f * LOG2E;
constexpr float QS_MLA = 0.07216878364870322f * LOG2E;
constexpr float QS_MEM = 0.08838834764831845f * LOG2E;

constexpr size_t al256(size_t x) { return (x + 255) & ~(size_t)255; }
constexpr size_t WS_CTL = 0;
constexpr size_t WS_SSQ = 32768;
constexpr size_t CTL_ZERO_BYTES = WS_SSQ + (size_t)3 * MTOK * 4;
constexpr int CW_BAR = 4096;
constexpr size_t WS_XRMS = al256(WS_SSQ + (size_t)3 * MTOK * 4);
constexpr size_t WS_GINV = WS_XRMS + (size_t)MTOK * 4;
constexpr size_t WS_WIN = al256(WS_GINV + (size_t)DM * 4);
constexpr size_t WS_WUQKV = WS_WIN + (size_t)INP * DM * 2;
constexpr size_t WS_WMEM = WS_WUQKV + (size_t)NQKV * 512 * 2;
constexpr size_t WS_WOUT = WS_WMEM + (size_t)1024 * DM * 2;
constexpr size_t WS_WGU = WS_WOUT + (size_t)DM * DM * 2;
constexpr size_t WS_WDN = WS_WGU + (size_t)2 * DFF * DM * 2;
constexpr size_t WS_XN = WS_WDN + (size_t)DM * DFF * 2;
constexpr size_t WS_Y = WS_XN + (size_t)MTOK * DM * 2;
constexpr size_t WS_MEMN = WS_Y + (size_t)MTOK * DM * 2;
constexpr size_t WS_KVM = WS_MEMN + (size_t)MMEM * INP * 2;
constexpr size_t WS_KVMP = WS_KVM + (size_t)MMEM * 1024 * 2;
constexpr size_t WS_BIG = WS_KVMP + (size_t)4 * MMEM * 1024 * 4;
constexpr size_t WS_PROJ = WS_BIG;
constexpr size_t WS_QKVB = WS_PROJ + (size_t)MTOK * INP * 2;
constexpr size_t WS_ACT = WS_BIG;
constexpr size_t WS_END1 = WS_QKVB + (size_t)MTOK * NQKV * 2, WS_END2 = WS_ACT + (size_t)MTOK * DFF * 2;
constexpr size_t WS_END = WS_END1 > WS_END2 ? WS_END1 : WS_END2;
static_assert(WS_END <= (size_t)512 * 1024 * 1024, "workspace map exceeds 512 MiB");

constexpr int RING_BYTES = 131072;
constexpr int MISC_OFF = RING_BYTES;
constexpr int LDS_BYTES = 147456;

__device__ __forceinline__ unsigned cvtpk(float lo, float hi) { f32x2_t v = {lo, hi}; bf16x2_t b = __builtin_convertvector(v, bf16x2_t); return __builtin_bit_cast(unsigned, b); }
__device__ __forceinline__ float bflo(unsigned w) { return __uint_as_float(w << 16); }
__device__ __forceinline__ float bfhi(unsigned w) { return __uint_as_float(w & 0xffff0000u); }
__device__ __forceinline__ float bf1(bf16_t v) { return __uint_as_float(((unsigned)v) << 16); }
__device__ __forceinline__ void unpack8(const u32x4 w, float (&f)[8]) {
    f[0] = bflo(w.x); f[1] = bfhi(w.x); f[2] = bflo(w.y); f[3] = bfhi(w.y); f[4] = bflo(w.z); f[5] = bfhi(w.z); f[6] = bflo(w.w); f[7] = bfhi(w.w); }
__device__ __forceinline__ u32x4 pack8(const float (&f)[8]) { u32x4 w; w.x = cvtpk(f[0], f[1]); w.y = cvtpk(f[2], f[3]); w.z = cvtpk(f[4], f[5]); w.w = cvtpk(f[6], f[7]); return w; }
template <int W> __device__ __forceinline__ float group_sum(float v) {
#pragma unroll
    for (int o = 1; o < W; o <<= 1) v += __shfl_xor(v, o);
    return v; }

__device__ __forceinline__ void rope_cs(int pos, int i, float& c, float& s) {
    const float inv = __builtin_amdgcn_exp2f(-(float)i * (13.287712379549449f / 32.0f));
    const float ang = (float)pos * inv;
    const float n = rintf(ang * 0.15915494309189535f);
    float r = fmaf(-n, 6.28125f, ang); r = fmaf(-n, 1.9353071795864769e-3f, r);
    const float rev = r * 0.15915494309189535f;
    s = __builtin_amdgcn_sinf(rev); c = __builtin_amdgcn_cosf(rev);
}


namespace pg8 {
constexpr int BM = 256, BK = 64, HALF = 128, HTB = HALF * BK * 2, STAGE_BYTES = 8 * HTB, NXCD = 8, WGM = 8;
__host__ __device__ __forceinline__ int lds_byte(int r, int c) { const int st = (r >> 4) * 2 + (c >> 5), rr = r & 15, cc = c & 31, ob = rr * 64 + cc * 2; return st * 1024 + (ob ^ (((ob >> 9) & 1) << 5)); }
__host__ __device__ __forceinline__ void stage_rc(int b, int& R, int& C) { const int st = b / 1024, sb = b % 1024, swz = sb ^ (((sb >> 9) & 1) << 5); R = (st >> 1) * 16 + swz / 64; C = (st & 1) * 32 + (swz % 64) / 2; }
__host__ __device__ __forceinline__ int perm32(int rho) { const int n = rho >> 4, i = rho & 15; return 8 * (i >> 2) + 4 * n + (i & 3); }

struct Unit { int pm, pn, kind, ks; };
struct Gemm { const bf16_t* A; const bf16_t* Bt; int lda, ldb, K, a_split_pn, a_split_off; };

struct StaticOrder {
    int nM, nN, nwg, G, c;
    __device__ void init(int M, int N, int G_, int c_) { nM = M / BM; nN = N / BM; nwg = nM * nN; G = G_; c = c_; }
    __device__ bool next(int i, Unit& u) const {
        const long L = (long)i * G + c; if (L >= nwg) return false;
        int wgid = (int)L; { const int q = nwg / NXCD, r = nwg % NXCD, xcd = wgid % NXCD, off = wgid / NXCD; wgid = (xcd < r ? xcd * (q + 1) : r * (q + 1) + (xcd - r) * q) + off; }
        const int nig = WGM * nN, gid = wgid / nig, fm = gid * WGM, gsz = (nM - fm) < WGM ? (nM - fm) : WGM;
        u.pm = fm + ((wgid % nig) % gsz); u.pn = (wgid % nig) / gsz; u.kind = 0; u.ks = 0; return true;
    }
    __device__ __forceinline__ void ptrs(const Gemm& g, const Unit& u, const char*& a, const char*& b) const {
        a = (const char*)g.A + (size_t)u.pm * (BM * 2) * g.lda + (u.pn >= g.a_split_pn ? (size_t)g.a_split_off * 2 : (size_t)0);
        b = (const char*)g.Bt + (size_t)u.pn * (BM * 2) * g.ldb;
    }
};
struct UpMemOrder {
    StaticOrder base; const bf16_t* memn; const bf16_t* wmems;
    __device__ void init(int M, int N, int G_, int c_, const bf16_t* memn_, const bf16_t* wmems_) { base.init(M, N, G_, c_); memn = memn_; wmems = wmems_; }
    __device__ bool next(int i, Unit& u) const {
        if (base.next(i, u)) return true;
        const long L = (long)i * base.G + base.c - base.nwg; if (L >= 64) return false;
        const int q = (int)L, tile = q >> 2; u.kind = 1; u.ks = q & 3; u.pm = tile >> 2; u.pn = tile & 3; return true;
    }
    __device__ __forceinline__ void ptrs(const Gemm& g, const Unit& u, const char*& a, const char*& b) const {
        if (u.kind == 0) { base.ptrs(g, u, a, b); return; }
        a = (const char*)memn + ((size_t)u.pm * BM * g.lda + (size_t)u.ks * 512) * 2;
        b = (const char*)wmems + ((size_t)u.ks * 1024 * 512 + (size_t)u.pn * BM * 512) * 2;
    }
};

struct EpiBf16 {
    static constexpr bool PERM = true; static constexpr int NPRE = 0;
    bf16_t* O; int ldc;
    __device__ __forceinline__ void operator()(const f32x4 (&acc)[2][2][4][2], const Unit& u, int wr, int wc, int fr, int fq) const {
        const int row0 = u.pm * BM + wr * 64 + fr, col0 = u.pn * BM + wc * 32 + 8 * fq;
#pragma unroll
        for (int ai = 0; ai < 2; ++ai)
#pragma unroll
            for (int m = 0; m < 4; ++m) { bf16_t* rowp = O + (size_t)(row0 + ai * HALF + m * 16) * ldc + col0;
#pragma unroll
                for (int bj = 0; bj < 2; ++bj) { const f32x4 v0 = acc[ai][bj][m][0], v1 = acc[ai][bj][m][1];
                    u32x4 w; w.x = cvtpk(v0[0], v0[1]); w.y = cvtpk(v0[2], v0[3]); w.z = cvtpk(v1[0], v1[1]); w.w = cvtpk(v1[2], v1[3]);
                    *(u32x4*)(rowp + bj * HALF) = w; } }
    }
};
struct EpiInProj {
    static constexpr bool PERM = true; static constexpr int NPRE = 0;
    bf16_t* O; float* ssq_cq; float* ssq_ckv; const float* g_ka; const float* g_kr; const int* positions;
    __device__ __forceinline__ void operator()(const f32x4 (&acc)[2][2][4][2], const Unit& u, int wr, int wc, int fr, int fq) const {
        const int row0 = u.pm * BM + wr * 64 + fr;
        const int pn = u.pn;
        if (pn == 4 || pn == 9) {
            const int cbase = pn * BM + 64 * wc + 8 * fq;
            const bool norm = (pn == 4) ? (wc < 2) : (wc == 0);
            const float* gg = (pn == 4) ? g_ka : g_kr;
            float gv[2][8];
#pragma unroll
            for (int bj = 0; bj < 2; ++bj)
#pragma unroll
                for (int i = 0; i < 8; ++i) gv[bj][i] = norm ? gg[32 * bj + 8 * fq + i] : 1.0f;
#pragma unroll
            for (int ai = 0; ai < 2; ++ai)
#pragma unroll
                for (int m = 0; m < 4; ++m) { const int row = row0 + ai * HALF + m * 16;
                    float v[2][8];
#pragma unroll
                    for (int bj = 0; bj < 2; ++bj)
#pragma unroll
                        for (int n = 0; n < 2; ++n)
#pragma unroll
                            for (int e = 0; e < 4; ++e) v[bj][4 * n + e] = acc[ai][bj][m][n][e];
                    {
                        float ss = 0.f;
#pragma unroll
                        for (int bj = 0; bj < 2; ++bj)
#pragma unroll
                            for (int i = 0; i < 8; ++i) ss += v[bj][i] * v[bj][i];
                        ss += __shfl_xor(ss, 16); ss += __shfl_xor(ss, 32);
                        const float rstd = norm ? __builtin_amdgcn_rsqf(ss * (1.0f / 64) + EPS) : 1.0f;
#pragma unroll
                        for (int bj = 0; bj < 2; ++bj)
#pragma unroll
                            for (int i = 0; i < 8; ++i) v[bj][i] *= rstd * gv[bj][i];
                        const bool rope = norm && (pn == 9);
                        const int pos = positions[row];
#pragma unroll
                        for (int i = 0; i < 8; ++i) { float c_, s_; rope_cs(pos, 8 * fq + i, c_, s_); if (!rope) { c_ = 1.0f; s_ = 0.0f; } const float x1 = v[0][i], x2 = v[1][i]; v[0][i] = x1 * c_ - x2 * s_; v[1][i] = x1 * s_ + x2 * c_; }
                    }
#pragma unroll
                    for (int bj = 0; bj < 2; ++bj) *(u32x4*)(O + (size_t)row * INP + cbase + 32 * bj) = pack8(v[bj]);
                }
            return;
        }
        const int col0 = pn * BM + wc * 32 + 8 * fq;
        float* ssq = (pn == 5 || pn == 6) ? ssq_cq : ((pn == 7 || pn == 8) ? ssq_ckv : nullptr);
#pragma unroll
        for (int ai = 0; ai < 2; ++ai)
#pragma unroll
            for (int m = 0; m < 4; ++m) { const int row = row0 + ai * HALF + m * 16; bf16_t* rowp = O + (size_t)row * INP + col0; float s = 0.f;
#pragma unroll
                for (int bj = 0; bj < 2; ++bj) { const f32x4 v0 = acc[ai][bj][m][0], v1 = acc[ai][bj][m][1];
                    u32x4 w; w.x = cvtpk(v0[0], v0[1]); w.y = cvtpk(v0[2], v0[3]); w.z = cvtpk(v1[0], v1[1]); w.w = cvtpk(v1[2], v1[3]);
                    *(u32x4*)(rowp + bj * HALF) = w;
                    s += (v0[0] * v0[0] + v0[1] * v0[1]) + (v0[2] * v0[2] + v0[3] * v0[3]) + (v1[0] * v1[0] + v1[1] * v1[1]) + (v1[2] * v1[2] + v1[3] * v1[3]); }
                if (ssq) { s += __shfl_xor(s, 16); s += __shfl_xor(s, 32); if (fq == 0) atomicAdd(ssq + row, s); } }
    }
};
struct EpiUpProj {
    static constexpr bool PERM = true; static constexpr int NPRE = 0;
    bf16_t* O; const float* ssq_cq; const float* ssq_ckv; float* kvmp; LAS float* xch; const float* g_kn;
    __device__ __forceinline__ void operator()(const f32x4 (&acc)[2][2][4][2], const Unit& u, int wr, int wc, int fr, int fq) const {
        const int row0 = u.pm * BM + wr * 64 + fr, col0 = u.pn * BM + wc * 32 + 8 * fq;
        if (u.kind == 1) {
#pragma unroll
            for (int ai = 0; ai < 2; ++ai)
#pragma unroll
                for (int m = 0; m < 4; ++m) { float* rowp = kvmp + ((size_t)u.ks * MMEM + row0 + ai * HALF + m * 16) * 1024 + col0;
#pragma unroll
                    for (int bj = 0; bj < 2; ++bj) { *(f32x4*)(rowp + bj * HALF) = acc[ai][bj][m][0]; *(f32x4*)(rowp + bj * HALF + 4) = acc[ai][bj][m][1]; } }
            return;
        }
        const float* ssq = (u.pn < 3) ? ssq_cq : ssq_ckv;
        float rstd[2][4];
#pragma unroll
        for (int ai = 0; ai < 2; ++ai)
#pragma unroll
            for (int m = 0; m < 4; ++m) rstd[ai][m] = __builtin_amdgcn_rsqf(ssq[row0 + ai * HALF + m * 16] * (1.0f / 512) + EPS);
        if (u.pn >= 3) {
#pragma unroll
            for (int ai = 0; ai < 2; ++ai)
#pragma unroll
                for (int m = 0; m < 4; ++m) { const f32x4 a0 = acc[ai][0][m][0] * rstd[ai][m], a1 = acc[ai][0][m][1] * rstd[ai][m];
                    float s = (a0[0] * a0[0] + a0[1] * a0[1]) + (a0[2] * a0[2] + a0[3] * a0[3]) + (a1[0] * a1[0] + a1[1] * a1[1]) + (a1[2] * a1[2] + a1[3] * a1[3]);
                    s += __shfl_xor(s, 16); s += __shfl_xor(s, 32);
                    if (fq == 0) xch[(ai * HALF + wr * 64 + m * 16 + fr) * 4 + wc] = s; }
            asm volatile("s_waitcnt lgkmcnt(0)" ::: "memory"); __builtin_amdgcn_s_barrier(); asm volatile("" ::: "memory");
            float gk[8];
#pragma unroll
            for (int i = 0; i < 8; ++i) gk[i] = g_kn[32 * wc + 8 * fq + i];
#pragma unroll
            for (int ai = 0; ai < 2; ++ai)
#pragma unroll
                for (int m = 0; m < 4; ++m) { const int row = row0 + ai * HALF + m * 16; bf16_t* rowp = O + (size_t)row * NQKV + col0;
                    const f32x4 ps = *(const LAS f32x4*)(xch + (ai * HALF + wr * 64 + m * 16 + fr) * 4);
                    const float r2 = __builtin_amdgcn_rsqf(((ps[0] + ps[1]) + (ps[2] + ps[3])) * (1.0f / 128) + EPS) * rstd[ai][m];
                    { const f32x4 v0 = acc[ai][0][m][0] * r2, v1 = acc[ai][0][m][1] * r2;
                      u32x4 w; w.x = cvtpk(v0[0] * gk[0], v0[1] * gk[1]); w.y = cvtpk(v0[2] * gk[2], v0[3] * gk[3]); w.z = cvtpk(v1[0] * gk[4], v1[1] * gk[5]); w.w = cvtpk(v1[2] * gk[6], v1[3] * gk[7]);
                      *(u32x4*)(rowp) = w; }
                    { const f32x4 v0 = acc[ai][1][m][0] * rstd[ai][m], v1 = acc[ai][1][m][1] * rstd[ai][m];
                      u32x4 w; w.x = cvtpk(v0[0], v0[1]); w.y = cvtpk(v0[2], v0[3]); w.z = cvtpk(v1[0], v1[1]); w.w = cvtpk(v1[2], v1[3]);
                      *(u32x4*)(rowp + HALF) = w; } }
            return;
        }
#pragma unroll
        for (int ai = 0; ai < 2; ++ai)
#pragma unroll
            for (int m = 0; m < 4; ++m) { const int row = row0 + ai * HALF + m * 16; bf16_t* rowp = O + (size_t)row * NQKV + col0;
#pragma unroll
                for (int bj = 0; bj < 2; ++bj) { const f32x4 v0 = acc[ai][bj][m][0] * rstd[ai][m], v1 = acc[ai][bj][m][1] * rstd[ai][m];
                    u32x4 w; w.x = cvtpk(v0[0], v0[1]); w.y = cvtpk(v0[2], v0[3]); w.z = cvtpk(v1[0], v1[1]); w.w = cvtpk(v1[2], v1[3]);
                    *(u32x4*)(rowp + bj * HALF) = w; } }
    }
};
struct EpiOutProj {
    static constexpr bool PERM = true; static constexpr int NPRE = 0;
    const bf16_t* xn; const float* xrms; const float* ginv; bf16_t* hb; float* ssq;
    __device__ __forceinline__ void operator()(const f32x4 (&acc)[2][2][4][2], const Unit& u, int wr, int wc, int fr, int fq) const {
        const int row0 = u.pm * BM + wr * 64 + fr, col0 = u.pn * BM + wc * 32 + 8 * fq;
        f32x4 gi[2][2];
#pragma unroll
        for (int bj = 0; bj < 2; ++bj) { gi[bj][0] = *(const f32x4*)(ginv + col0 + bj * HALF); gi[bj][1] = *(const f32x4*)(ginv + col0 + bj * HALF + 4); }
#pragma unroll
        for (int ai = 0; ai < 2; ++ai) {
            u32x4 xv[4][2]; float rm[4];
#pragma unroll
            for (int m = 0; m < 4; ++m) { const int row = row0 + ai * HALF + m * 16; const size_t off = (size_t)row * DM + col0; rm[m] = xrms[row];
#pragma unroll
                for (int bj = 0; bj < 2; ++bj) xv[m][bj] = *(const u32x4*)(xn + off + bj * HALF); }
            asm volatile("" ::: "memory");
#pragma unroll
            for (int m = 0; m < 4; ++m) { const int row = row0 + ai * HALF + m * 16; const size_t off = (size_t)row * DM + col0; float s = 0.f;
#pragma unroll
                for (int bj = 0; bj < 2; ++bj) { const u32x4 xw = xv[m][bj]; const float r = rm[m];
                    f32x4 x0, x1; x0[0] = bflo(xw.x); x0[1] = bfhi(xw.x); x0[2] = bflo(xw.y); x0[3] = bfhi(xw.y); x1[0] = bflo(xw.z); x1[1] = bfhi(xw.z); x1[2] = bflo(xw.w); x1[3] = bfhi(xw.w);
                    const f32x4 h0 = x0 * (gi[bj][0] * r) + acc[ai][bj][m][0], h1 = x1 * (gi[bj][1] * r) + acc[ai][bj][m][1];
                    u32x4 w; w.x = cvtpk(h0[0], h0[1]); w.y = cvtpk(h0[2], h0[3]); w.z = cvtpk(h1[0], h1[1]); w.w = cvtpk(h1[2], h1[3]);
                    *(u32x4*)(hb + off + bj * HALF) = w;
                    s += (h0[0] * h0[0] + h0[1] * h0[1]) + (h0[2] * h0[2] + h0[3] * h0[3]) + (h1[0] * h1[0] + h1[1] * h1[1]) + (h1[2] * h1[2] + h1[3] * h1[3]); }
                s += __shfl_xor(s, 16); s += __shfl_xor(s, 32);
                if (fq == 0) atomicAdd(ssq + row, s); }
            asm volatile("" ::: "memory");
        }
    }
};
struct EpiSwiGLU {
    static constexpr bool PERM = true; static constexpr int NPRE = 8;
    bf16_t* act; const float* ssq;
    __device__ __forceinline__ void pre(float (&p)[8], const Unit& u, int wr, int wc, int fr, int fq) const {
        const int row0 = u.pm * BM + wr * 64 + fr;
#pragma unroll
        for (int ai = 0; ai < 2; ++ai)
#pragma unroll
            for (int m = 0; m < 4; ++m) p[ai * 4 + m] = ssq[row0 + ai * HALF + m * 16];
    }
    __device__ __forceinline__ void operator()(const f32x4 (&acc)[2][2][4][2], const Unit& u, int wr, int wc, int fr, int fq, const float (&p)[8]) const {
        const int row0 = u.pm * BM + wr * 64 + fr, col0 = u.pn * HALF + wc * 32 + 8 * fq;
        float sq[2][4];
#pragma unroll
        for (int ai = 0; ai < 2; ++ai)
#pragma unroll
            for (int m = 0; m < 4; ++m) sq[ai][m] = p[ai * 4 + m];
#pragma unroll
        for (int ai = 0; ai < 2; ++ai)
#pragma unroll
            for (int m = 0; m < 4; ++m) { const int row = row0 + ai * HALF + m * 16;
                const float rstd = __builtin_amdgcn_rsqf(sq[ai][m] * (1.0f / DM) + EPS);
                float a[8];
#pragma unroll
                for (int n = 0; n < 2; ++n)
#pragma unroll
                    for (int e = 0; e < 4; ++e) { const float g = acc[ai][0][m][n][e] * rstd, up = acc[ai][1][m][n][e] * rstd;
                        const float sg = g * __builtin_amdgcn_rcpf(1.0f + __builtin_amdgcn_exp2f(-g * LOG2E));
                        a[n * 4 + e] = sg * up; }
                *(u32x4*)(act + (size_t)row * DFF + col0) = pack8(a); }
    }
};
struct EpiDown {
    static constexpr bool PERM = true; static constexpr int NPRE = 0;
    float* out; const bf16_t* hb;
    __device__ __forceinline__ void operator()(const f32x4 (&acc)[2][2][4][2], const Unit& u, int wr, int wc, int fr, int fq) const {
        const int row0 = u.pm * BM + wr * 64 + fr, col0 = u.pn * BM + wc * 32 + 8 * fq;
        u32x4 hw[2][4][2];
#pragma unroll
        for (int ai = 0; ai < 2; ++ai)
#pragma unroll
            for (int m = 0; m < 4; ++m) { const size_t off = (size_t)(row0 + ai * HALF + m * 16) * DM + col0;
#pragma unroll
                for (int bj = 0; bj < 2; ++bj) hw[ai][m][bj] = *(const u32x4*)(hb + off + bj * HALF); }
        asm volatile("" ::: "memory");
#pragma unroll
        for (int ai = 0; ai < 2; ++ai)
#pragma unroll
            for (int m = 0; m < 4; ++m) { const size_t off = (size_t)(row0 + ai * HALF + m * 16) * DM + col0;
#pragma unroll
                for (int bj = 0; bj < 2; ++bj) { const u32x4 w = hw[ai][m][bj];
                    f32x4 h0, h1; h0[0] = bflo(w.x); h0[1] = bfhi(w.x); h0[2] = bflo(w.y); h0[3] = bfhi(w.y); h1[0] = bflo(w.z); h1[1] = bfhi(w.z); h1[2] = bflo(w.w); h1[3] = bfhi(w.w);
                    *(f32x4*)(out + off + bj * HALF) = h0 + acc[ai][bj][m][0]; *(f32x4*)(out + off + bj * HALF + 4) = h1 + acc[ai][bj][m][1]; } }
    }
};

template <class Epi, class Sched, bool ALIGN_EPI = true>
__device__ __forceinline__ void gemm_phase(LAS unsigned char* lds, const Gemm g, const Sched& S, const Epi& E) {
    const int tid = threadIdx.x, wid = __builtin_amdgcn_readfirstlane(tid >> 6), lane = tid & 63, wr = wid >> 2, wc = wid & 3, fr = lane & 15, fq = lane >> 4;
    const int K = g.K, nt = K / BK;
    unsigned voffA[2], voffB[2];
#pragma unroll
    for (int i = 0; i < 2; ++i) { int R, C; stage_rc(tid * 16 + i * 8192, R, C); const int Rb = Epi::PERM ? ((R & ~31) + perm32(R & 31)) : R;
        voffA[i] = (unsigned)(R * g.lda + C) * 2u; voffB[i] = (unsigned)(Rb * g.ldb + C) * 2u; }
    const size_t kstep = (size_t)(BK * 2);
    const size_t hstepA = (size_t)HALF * g.lda * 2, hstepB = (size_t)HALF * g.ldb * 2;
    const unsigned ldsw = (unsigned)wid * 1024u;
    const int aoff = lds_byte(wr * 64 + fr, fq * 8), boff = lds_byte(wc * 32 + fr, fq * 8);
#define PG8_SA(b, h) (((b) * 2 + (h)) * HTB)
#define PG8_SB(b, h) ((4 + (b) * 2 + (h)) * HTB)
#define PG8_STAGE(bufoff, gbase, voff) do { _Pragma("unroll") for (int _i = 0; _i < 2; ++_i) \
        __builtin_amdgcn_global_load_lds((const unsigned*)((const char*)(gbase) + (voff)[_i]), (LAS unsigned*)(lds + (bufoff) + ldsw + _i * 8192), 16, 0, 0); } while (0)
#define PG8_LDA(dst, b, h) do { _Pragma("unroll") for (int m = 0; m < 4; ++m) _Pragma("unroll") for (int k = 0; k < 2; ++k) dst[m][k] = *(const LAS bf16x8*)(lds + PG8_SA(b, h) + aoff + m * 2048 + k * 1024); } while (0)
#define PG8_LDB(dst, b, h) do { _Pragma("unroll") for (int n = 0; n < 2; ++n) _Pragma("unroll") for (int k = 0; k < 2; ++k) dst[n][k] = *(const LAS bf16x8*)(lds + PG8_SB(b, h) + boff + n * 2048 + k * 1024); } while (0)
#define PG8_MMA(ai, bj, At, Bt) do { __builtin_amdgcn_s_setprio(1); _Pragma("unroll") for (int m = 0; m < 4; ++m) _Pragma("unroll") for (int n = 0; n < 2; ++n) _Pragma("unroll") for (int k = 0; k < 2; ++k) \
        acc[ai][bj][m][n] = __builtin_amdgcn_mfma_f32_16x16x32_bf16(Bt[n][k], At[m][k], acc[ai][bj][m][n], 0, 0, 0); __builtin_amdgcn_s_setprio(0); } while (0)
#define PG8_WAIT_V(n) asm volatile("s_waitcnt vmcnt(" #n ")" ::: "memory")
#define PG8_WAIT_L(n) asm volatile("s_waitcnt lgkmcnt(" #n ")" ::: "memory")
#define PG8_BAR __builtin_amdgcn_s_barrier()
#define PG8_SCHED __builtin_amdgcn_sched_barrier(0)
    Unit cur, nxt; int ui = 0;
    if (!S.next(0, cur)) return;
    f32x4 acc[2][2][4][2];
#pragma unroll
    for (int a = 0; a < 2; ++a)
#pragma unroll
        for (int b = 0; b < 2; ++b)
#pragma unroll
            for (int m = 0; m < 4; ++m)
#pragma unroll
                for (int n = 0; n < 2; ++n) acc[a][b][m][n] = (f32x4){0.f, 0.f, 0.f, 0.f};
    bf16x8 At[4][2], B0[2][2], B1[2][2];
    float epf[Epi::NPRE > 0 ? Epi::NPRE : 1];
    const char* cA; const char* cB; S.ptrs(g, cur, cA, cB);
    PG8_STAGE(PG8_SB(0, 0), cB, voffB); PG8_STAGE(PG8_SB(0, 1), cB + hstepB, voffB); PG8_STAGE(PG8_SA(0, 0), cA, voffA); PG8_STAGE(PG8_SA(0, 1), cA + hstepA, voffA);
    if (wr == 1) PG8_BAR;
    PG8_WAIT_V(2); PG8_BAR;
    PG8_STAGE(PG8_SB(1, 0), cB + kstep, voffB); PG8_STAGE(PG8_SA(1, 0), cA + kstep, voffA); PG8_STAGE(PG8_SB(1, 1), cB + hstepB + kstep, voffB);
    PG8_WAIT_V(6); PG8_BAR;
    for (;;) {
        const bool has_next = S.next(ui + 1, nxt);
        const char* nA = cA; const char* nB = cB; if (has_next) S.ptrs(g, nxt, nA, nB);
        for (int t = 0; t < nt; t += 2) {
            const bool last = (t == nt - 2);
            if constexpr (Epi::NPRE > 0) { if (last) E.pre(epf, cur, wr, wc, fr, fq); }
            const char* a1 = cA + (size_t)(t + 1) * kstep;
            const char* a2 = last ? nA : cA + (size_t)(t + 2) * kstep; const char* b2 = last ? nB : cB + (size_t)(t + 2) * kstep;
            const char* a3 = a2 + kstep; const char* b3 = b2 + kstep;
            PG8_LDB(B0, 0, 0); PG8_LDB(B1, 0, 1); PG8_SCHED; PG8_LDA(At, 0, 0); PG8_STAGE(PG8_SA(1, 1), a1 + hstepA, voffA);
            PG8_WAIT_V(8); PG8_WAIT_L(0); PG8_BAR; PG8_MMA(0, 0, At, B0); PG8_MMA(0, 1, At, B1); PG8_BAR; PG8_SCHED;
            PG8_LDA(At, 0, 1); PG8_STAGE(PG8_SB(0, 0), b2, voffB); PG8_STAGE(PG8_SB(0, 1), b2 + hstepB, voffB); PG8_STAGE(PG8_SA(0, 0), a2, voffA);
            PG8_WAIT_V(8); PG8_WAIT_L(0); PG8_BAR; PG8_MMA(1, 0, At, B0); PG8_MMA(1, 1, At, B1); PG8_BAR; PG8_SCHED;
            PG8_LDB(B0, 1, 0); PG8_LDB(B1, 1, 1); PG8_SCHED; PG8_LDA(At, 1, 0); PG8_STAGE(PG8_SA(0, 1), a2 + hstepA, voffA);
            PG8_WAIT_V(8); PG8_WAIT_L(0); PG8_BAR; PG8_MMA(0, 0, At, B0); PG8_MMA(0, 1, At, B1); PG8_BAR; PG8_SCHED;
            PG8_LDA(At, 1, 1); PG8_STAGE(PG8_SB(1, 0), b3, voffB); PG8_STAGE(PG8_SB(1, 1), b3 + hstepB, voffB); PG8_STAGE(PG8_SA(1, 0), a3, voffA);
            PG8_WAIT_V(8); PG8_WAIT_L(0); PG8_BAR; PG8_MMA(1, 0, At, B0); PG8_MMA(1, 1, At, B1); PG8_BAR; PG8_SCHED;
        }
        if constexpr (ALIGN_EPI) { if (wr == 0) PG8_BAR; }
        if constexpr (Epi::NPRE > 0) E(acc, cur, wr, wc, fr, fq, epf); else E(acc, cur, wr, wc, fr, fq);
        if (!has_next) break;
#pragma unroll
        for (int a = 0; a < 2; ++a)
#pragma unroll
            for (int b = 0; b < 2; ++b)
#pragma unroll
                for (int m = 0; m < 4; ++m)
#pragma unroll
                    for (int n = 0; n < 2; ++n) acc[a][b][m][n] = (f32x4){0.f, 0.f, 0.f, 0.f};
        cur = nxt; cA = nA; cB = nB; ++ui;
        if constexpr (ALIGN_EPI) { if (wr == 1) PG8_BAR; }
    }
    PG8_WAIT_V(0);
    if constexpr (!ALIGN_EPI) { if (wr == 0) PG8_BAR; }
    PG8_BAR;
#undef PG8_SA
#undef PG8_SB
#undef PG8_STAGE
#undef PG8_LDA
#undef PG8_LDB
#undef PG8_MMA
#undef PG8_WAIT_V
#undef PG8_WAIT_L
#undef PG8_BAR
#undef PG8_SCHED
}
}


#define XB_TMO      128
#define XB_XCNT(j)  (256  + 64 * (j))
#define XB_XSUB(j)  (1280 + 64 * (j))
#define XB_XGEN(j)  (2304 + 64 * (j))
#define XB_TOP      3328
#define XB_TOPGEN   3392
#define XCD_BAR_WORDS 3456
#define XB_SPIN_CAP (1u << 18)
__device__ __forceinline__ unsigned xb_ld(unsigned* p)              { return __hip_atomic_load(p, __ATOMIC_RELAXED, __HIP_MEMORY_SCOPE_AGENT); }
__device__ __forceinline__ unsigned xb_add(unsigned* p, unsigned v) { return __hip_atomic_fetch_add(p, v, __ATOMIC_RELAXED, __HIP_MEMORY_SCOPE_AGENT); }
__device__ __forceinline__ unsigned xb_xcc_id() { return (unsigned)__builtin_amdgcn_s_getreg((3 << 11) | 20) & 0xFu; }
#define XB_SPIN(cond, bar) do { unsigned _sp = 0; while (cond) { __builtin_amdgcn_s_sleep(1); \
    if ((++_sp & 255u) == 0u) { if (xb_ld(&(bar)[XB_TMO])) break; if (_sp > XB_SPIN_CAP) { atomicAdd(&(bar)[XB_TMO], 1u); break; } } } } while (0)
struct XcdBarrier { unsigned* bar; unsigned x; volatile LAS unsigned* st; };
__device__ __forceinline__ XcdBarrier xcd_barrier_post(unsigned* bar, volatile LAS unsigned* st) {
    XcdBarrier b; b.bar = bar; b.x = xb_xcc_id(); b.st = st;
    if (threadIdx.x == 0) (void)xb_add(&bar[XB_XCNT(b.x)], 1u);
    return b;
}
__device__ __forceinline__ void xcd_barrier_complete(unsigned* bar, unsigned x, unsigned& nloc, unsigned& nx) {
    const unsigned G = gridDim.x * gridDim.y * gridDim.z;
    unsigned sum, cnt, mine, sp = 0u;
    for (;;) {
        sum = 0u; cnt = 0u; mine = 0u;
#pragma unroll
        for (unsigned j = 0; j < 16; ++j) { const unsigned c = xb_ld(&bar[XB_XCNT(j)]); sum += c; cnt += (c > 0u) ? 1u : 0u; mine = (j == x) ? c : mine; }
        if (sum == G) break;
        __builtin_amdgcn_s_sleep(1);
        if ((++sp & 255u) == 0u) { if (xb_ld(&bar[XB_TMO])) break; if (sp > XB_SPIN_CAP) { atomicAdd(&bar[XB_TMO], 1u); break; } }
    }
    nloc = mine > 0u ? mine : 1u; nx = cnt > 0u ? cnt : 1u;
}
__device__ __forceinline__ void xcd_barrier(const XcdBarrier& b) {
    asm volatile("s_waitcnt vmcnt(0)" ::: "memory");
    __syncthreads();
    if (threadIdx.x == 0) {
        unsigned* bar = b.bar;
        __builtin_amdgcn_s_waitcnt(0);
        unsigned nloc = b.st[0], nx = b.st[1];
        if (nloc == 0u) { xcd_barrier_complete(bar, b.x, nloc, nx); b.st[0] = nloc; b.st[1] = nx; }
        const unsigned old = xb_add(&bar[XB_XSUB(b.x)], 1u);
        const unsigned gen = old / nloc;
        if (old + 1u == (gen + 1u) * nloc) {
            __builtin_amdgcn_fence(__ATOMIC_RELEASE, "agent");
            asm volatile("s_waitcnt vmcnt(0)" ::: "memory");
            const unsigned og = xb_add(&bar[XB_TOP], 1u);
            const unsigned tg = og / nx;
            if (og + 1u == (tg + 1u) * nx) xb_add(&bar[XB_TOPGEN], 1u);
            else XB_SPIN(xb_ld(&bar[XB_TOPGEN]) == tg, bar);
            __builtin_amdgcn_fence(__ATOMIC_ACQUIRE, "agent");
            xb_add(&bar[XB_XGEN(b.x)], 1u);
            asm volatile("s_waitcnt vmcnt(0)" ::: "memory");
        } else {
            XB_SPIN(xb_ld(&bar[XB_XGEN(b.x)]) == gen, bar);
            __builtin_amdgcn_fence(__ATOMIC_ACQUIRE, "agent");
            asm volatile("s_waitcnt vmcnt(0)" ::: "memory");
        }
    }
    __syncthreads();
}

struct Args { const void* in[25]; float* out; unsigned char* ws; int lo, hi, att_lo, att_hi; };

__device__ __forceinline__ void p0_transpose_item(const float* W, int K, int N, bf16_t* WT, int mode, const float* kscale, LAS unsigned* scr, int item, int lane, int kslice = 0) {
    const int nblk = N / 64, kb = item / nblk, nb = item % nblk, k0 = 64 * kb, n0 = 64 * nb;
    const int lr = lane >> 4, lc = (lane & 15) * 4;
    f32x4 va[8], vb[8];
#pragma unroll
    for (int i = 0; i < 8; ++i) { const int kp = lr + 4 * i; const float* p = W + (size_t)(k0 + 2 * kp) * N + n0 + lc; va[i] = *(const f32x4*)p; vb[i] = *(const f32x4*)(p + N); }
#pragma unroll
    for (int i = 0; i < 8; ++i) { const int kp = lr + 4 * i;
        if (kscale) { const float s0 = kscale[k0 + 2 * kp], s1 = kscale[k0 + 2 * kp + 1]; va[i] = va[i] * s0; vb[i] = vb[i] * s1; }
        LAS unsigned* d = scr + kp * 65 + lc;
        d[0] = cvtpk(va[i].x, vb[i].x); d[1] = cvtpk(va[i].y, vb[i].y); d[2] = cvtpk(va[i].z, vb[i].z); d[3] = cvtpk(va[i].w, vb[i].w); }
    asm volatile("s_waitcnt lgkmcnt(0)" ::: "memory");
    const int c = lane & 7;
    const bool special = (mode == 3) && ((n0 >> 8) == 4 || (n0 >> 8) == 9);
    const int r0 = (mode == 0 || mode == 3) ? n0 : ((n0 >> 7) * 256 + (n0 & 127) + (mode == 2 ? 128 : 0));
#pragma unroll
    for (int j = 0; j < 8; ++j) { const int n = (lane >> 3) + 8 * j; const LAS unsigned* sp = scr + (4 * c) * 65 + n;
        u32x4 o; o.x = sp[0]; o.y = sp[65]; o.z = sp[130]; o.w = sp[195];
        const int row = special ? ((n0 & ~255) + 128 * (n >> 5) + 32 * ((n0 >> 6) & 3) + (n & 31)) : (r0 + n);
        if (kslice) *(u32x4*)(WT + (size_t)(k0 / kslice) * N * kslice + (size_t)row * kslice + (k0 % kslice) + 8 * c) = o;
        else *(u32x4*)(WT + (size_t)row * K + k0 + 8 * c) = o; }
    asm volatile("s_waitcnt lgkmcnt(0)" ::: "memory");
}
__device__ __forceinline__ void rms_row2_to_bf16(const float* xrow0, const float* xrow1, const float* g, bf16_t* orow0, bf16_t* orow1, int lane, float* rms0 = nullptr) {
    const f32x4* xa = (const f32x4*)xrow0 + lane; const f32x4* xb = (const f32x4*)xrow1 + lane; const f32x4* gr = (const f32x4*)g + lane;
    f32x4 va[8], vb[8]; float sa = 0.f, sb = 0.f;
#pragma unroll
    for (int j = 0; j < 8; ++j) { va[j] = xa[64 * j]; vb[j] = xb[64 * j]; }
#pragma unroll
    for (int j = 0; j < 8; ++j) { sa += (va[j].x * va[j].x + va[j].y * va[j].y) + (va[j].z * va[j].z + va[j].w * va[j].w); sb += (vb[j].x * vb[j].x + vb[j].y * vb[j].y) + (vb[j].z * vb[j].z + vb[j].w * vb[j].w); }
    const float qa = sqrtf(group_sum<64>(sa) * (1.0f / DM) + EPS), qb = sqrtf(group_sum<64>(sb) * (1.0f / DM) + EPS);
    const float ra = 1.0f / qa, rb = 1.0f / qb;
    if (rms0 && lane == 0) { rms0[0] = qa; rms0[1] = qb; }
    u32x2* oa = (u32x2*)orow0 + lane; u32x2* ob = (u32x2*)orow1 + lane;
#pragma unroll
    for (int j = 0; j < 8; ++j) { const f32x4 gg = gr[64 * j];
        u32x2 w; w.x = cvtpk(va[j].x * ra * gg.x, va[j].y * ra * gg.y); w.y = cvtpk(va[j].z * ra * gg.z, va[j].w * ra * gg.w); oa[64 * j] = w;
        u32x2 w2; w2.x = cvtpk(vb[j].x * rb * gg.x, vb[j].y * rb * gg.y); w2.y = cvtpk(vb[j].z * rb * gg.z, vb[j].w * rb * gg.w); ob[64 * j] = w2; }
}

constexpr int N_MLA_UNITS = 256, N_MEM_UNITS = 64, N_SWA_UNITS = 256, N_ATT_UNITS = N_MLA_UNITS + N_MEM_UNITS + N_SWA_UNITS;
constexpr int CV_OUT = (DM / 64) * (DM / 64), CV_G = (DM / 64) * (DFF / 64), CV_DN = (DFF / 64) * (DM / 64), CV_ITEMS = CV_OUT + 2 * CV_G + CV_DN, N_CONV_UNITS = CV_ITEMS / 8;
static_assert(CV_ITEMS % 8 == 0, "conversion items per unit");
constexpr int N_QUEUE_UNITS = N_ATT_UNITS + N_CONV_UNITS;
__device__ __forceinline__ int crow(int r, int hi) { return (r & 3) + 8 * (r >> 2) + 4 * hi; }


template <int S0, int NSEG> __device__ __forceinline__ float qseg_rstd(const bf16x8* qf, float qscale) {
    float ss = 0.f;
#pragma unroll
    for (int s = 0; s < NSEG; ++s) { float f[8]; unpack8(__builtin_bit_cast(u32x4, qf[S0 + s]), f);
#pragma unroll
        for (int j = 0; j < 8; ++j) ss += f[j] * f[j]; }
    ss += __shfl_xor(ss, 32);
    return 1.0f / sqrtf(ss * (1.0f / (16 * NSEG)) + EPS) * qscale;
}
__device__ __forceinline__ void qfrag_scale(const bf16x8 q, const float* g, float rstd, float (&f)[8]) {
    unpack8(__builtin_bit_cast(u32x4, q), f);
    const f32x4 g0 = *(const f32x4*)g, g1 = *(const f32x4*)(g + 4);
    f[0] *= rstd * g0[0]; f[1] *= rstd * g0[1]; f[2] *= rstd * g0[2]; f[3] *= rstd * g0[3];
    f[4] *= rstd * g1[0]; f[5] *= rstd * g1[1]; f[6] *= rstd * g1[2]; f[7] *= rstd * g1[3];
}
template <int S0, int NSEG> __device__ __forceinline__ void qseg_norm(bf16x8* qf, const float* g, float qscale, int hi) {
    const float rstd = qseg_rstd<S0, NSEG>(qf, qscale);
#pragma unroll
    for (int s = 0; s < NSEG; ++s) { float f[8]; qfrag_scale(qf[S0 + s], g + 16 * s + 8 * hi, rstd, f); qf[S0 + s] = __builtin_bit_cast(bf16x8, pack8(f)); }
}
__device__ __forceinline__ void at_glds16(const void* gsrc, unsigned lds_dst) { unsigned keep;
    asm volatile("s_mov_b32 %0, m0\n\ts_mov_b32 m0, %2\n\ts_nop 0\n\tglobal_load_lds_dwordx4 %1, off\n\ts_mov_b32 m0, %0" : "=&s"(keep) : "v"(gsrc), "s"(lds_dst) : "memory"); }
template <int N> __device__ __forceinline__ void at_wait_vm() { asm volatile("s_waitcnt vmcnt(%0)" :: "n"(N) : "memory"); }
template <int D0, int D1> __device__ __forceinline__ const char* at_ksrc3(const bf16_t* k0, int ld0, const bf16_t* k1, int ld1, int key0, int col0, unsigned ko0, unsigned ko1) {
    if constexpr (D1 == 0) { return (const char*)k0 + ((size_t)key0 * ld0 + col0) * 2 + ko0; }
    else { return (col0 < D0) ? ((const char*)k0 + ((size_t)key0 * ld0 + col0) * 2 + ko0) : ((const char*)k1 + ((size_t)key0 * ld1 + (col0 - D0)) * 2 + ko1); }
}
template <int D0, int D1> __device__ __forceinline__ const char* at_ksrc2(const bf16_t* k0, int ld0, const bf16_t* k1, int ld1, int t, int c, unsigned ko0, unsigned ko1) {
    if constexpr (D1 == 0) { return (const char*)k0 + ((size_t)t * 64 * ld0 + c * 8) * 2 + ko0; }
    else { return (c * 8 < D0) ? ((const char*)k0 + ((size_t)t * 64 * ld0 + c * 8) * 2 + ko0) : ((const char*)k1 + ((size_t)t * 64 * ld1 + (c * 8 - D0)) * 2 + ko1); }
}
template <int D0, int D1> __device__ __forceinline__ const bf16_t* at_ksrc(const bf16_t* k0, int ld0, const bf16_t* k1, int ld1, size_t key, int c) {
    if constexpr (D1 == 0) { return k0 + key * ld0 + c * 8; }
    else { return (c * 8 < D0) ? (k0 + key * ld0 + c * 8) : (k1 + key * ld1 + (c * 8 - D0)); }
}
template <int D0, int D1, int DV, int MODE>
__device__ __forceinline__ void attn_unit(LAS unsigned char* lds, const bf16_t* qw, int q_ld, const bf16_t* k0, int ld0, const bf16_t* k1, int ld1, const bf16_t* vp, int ldv,
                                          bf16_t* ow, int o_ld, int t_begin, int t_end,
                                          int qabs  , int wave_tmax  , int wave_tmin,
                                          float slope2, float sink2, int pos_q, const int* posk_g  , bool first_block, const float* qg0, const float* qg1) {
    constexpr int DQK = D0 + D1, NKC = DQK / 8, KBYTES = DQK * 128, VBYTES = DV * 128, TBYTES = KBYTES + VBYTES, KI = NKC / 8, VI = DV / 64  , NS = DQK / 16, NDB = DV / 32;
    constexpr int NDMA = KI + VI;
    static_assert(3 * TBYTES + 1024 <= RING_BYTES, "attention LDS");
    int tid_ = threadIdx.x; asm volatile("" : "+v"(tid_));
    asm volatile("" : "+s"(qg0), "+s"(qg1));
    asm volatile("" : "+s"(t_begin), "+s"(t_end));
    const int tid = tid_, lane = tid & 63, wid = __builtin_amdgcn_readfirstlane(tid >> 6), r32 = lane & 31, hi = lane >> 5;
    LAS float* poskf = (LAS float*)(lds + 3 * TBYTES); const float pos_qf = (float)pos_q;
    const int voff = ((4 * hi + ((lane & 15) >> 2)) * 64) + (((lane >> 4) & 1) * 32) + ((lane & 3) * 8);
    const unsigned lds0 = (unsigned)(size_t)lds;
    const unsigned kr_ = (unsigned)(lane >> 3), kc_ = ((unsigned)(lane & 7) ^ kr_ ^ (unsigned)((wid >> 1) & 1));
    const unsigned ko0 = kr_ * (unsigned)ld0 * 2u + kc_ * 16u, ko1 = kr_ * (unsigned)ld1 * 2u + kc_ * 16u, vo = ((unsigned)(lane >> 2) * (unsigned)ldv + (unsigned)(lane & 3) * 8u) * 2u;
    unsigned kro[4];
#pragma unroll
    for (int j = 0; j < 4; ++j) kro[j] = (unsigned)((r32 >> 3) * 1024 + (r32 & 7) * 128) + (((unsigned)(2 * j + hi) ^ (unsigned)(r32 & 7) ^ (unsigned)((r32 >> 4) & 1)) * 16u);
#define AT_DMA(t, b) do { \
        _Pragma("unroll") for (int i = 0; i < KI; ++i) {   \
            const char* src = at_ksrc3<D0, D1>(k0, ld0, k1, ld1, (t) * 64 + 8 * wid, i * 64, ko0, ko1); \
            at_glds16(src, (unsigned)__builtin_amdgcn_readfirstlane((int)(lds0 + (unsigned)((b) * TBYTES + (i * 8 + wid) * 1024)))); } \
        _Pragma("unroll") for (int i = 0; i < VI; ++i) { const int p = wid + 8 * i, dblk = p >> 2, ks = p & 3; \
            const char* src = (const char*)vp + (((size_t)(t) * 64 + ks * 16) * ldv + dblk * 32) * 2 + vo; \
            at_glds16(src, (unsigned)__builtin_amdgcn_readfirstlane((int)(lds0 + (unsigned)((b) * TBYTES + KBYTES + p * 1024)))); } } while (0)
#define AT_BAR() do { asm volatile("" ::: "memory"); __builtin_amdgcn_s_barrier(); asm volatile("" ::: "memory"); } while (0)
    const int nt = t_end - t_begin;
    AT_DMA(t_begin, 0);
    if (nt > 1) AT_DMA(t_begin + 1, 1);
    if constexpr (MODE == 2) { if (tid < 256) poskf[tid] = (first_block && tid < 128) ? 0.f : (float)posk_g[tid]; }
    bf16x8 qf[NS];
#pragma unroll
    for (int s = 0; s < NS; ++s) qf[s] = *(const bf16x8*)(qw + (size_t)r32 * q_ld + 16 * s + 8 * hi);
    if constexpr (MODE == 0) qseg_norm<0, 8>(qf, qg0, QS_MEM, hi);
    if constexpr (MODE == 2) qseg_norm<0, 4>(qf, qg0, QS_SWA, hi);
    if constexpr (MODE == 1) {
        qseg_norm<0, 8>(qf, qg0, QS_MLA, hi);
        const float rstd = qseg_rstd<8, 4>(qf, QS_MLA);
#pragma unroll
        for (int sp = 0; sp < 2; ++sp) { float fa[8], fb[8]; qfrag_scale(qf[8 + sp], qg1 + 16 * sp + 8 * hi, rstd, fa); qfrag_scale(qf[10 + sp], qg1 + 16 * (sp + 2) + 8 * hi, rstd, fb);
#pragma unroll
            for (int j = 0; j < 8; ++j) { float c_, s_; rope_cs(pos_q, 16 * sp + 8 * hi + j, c_, s_); const float x1 = fa[j], x2 = fb[j]; fa[j] = x1 * c_ - x2 * s_; fb[j] = x1 * s_ + x2 * c_; }
            qf[8 + sp] = __builtin_bit_cast(bf16x8, pack8(fa)); qf[10 + sp] = __builtin_bit_cast(bf16x8, pack8(fb)); }
    }
    f32x16 o[NDB];
#pragma unroll
    for (int d = 0; d < NDB; ++d)
#pragma unroll
        for (int r = 0; r < 16; ++r) o[d][r] = 0.f;
    float m_run = (MODE == 2) ? sink2 : -1e30f, l_run = (MODE == 2 && hi == 0) ? 1.f : 0.f;
    if (nt > 1) at_wait_vm<NDMA>(); else at_wait_vm<0>();
    asm volatile("s_waitcnt lgkmcnt(0)" ::: "memory");
    AT_BAR();
    constexpr int NG = NS / 2;
#define AT_KRD(dst, g) do { _Pragma("unroll") for (int s4 = 0; s4 < 2; ++s4) { const int s_ = (g) * 2 + s4; dst[s4][0] = *(const LAS bf16x8*)(kb + kro[s_ & 3] + (s_ >> 2) * 8192); dst[s4][1] = *(const LAS bf16x8*)(kb + kro[s_ & 3] + (s_ >> 2) * 8192 + 4096); } } while (0)
#define AT_KMM(src, g) do { _Pragma("unroll") for (int s4 = 0; s4 < 2; ++s4) { p0 = __builtin_amdgcn_mfma_f32_32x32x16_bf16(src[s4][0], qf[(g) * 2 + s4], p0, 0, 0, 0); p1 = __builtin_amdgcn_mfma_f32_32x32x16_bf16(src[s4][1], qf[(g) * 2 + s4], p1, 0, 0, 0); } } while (0)
#define AT_VRD(dst, d) do { _Pragma("unroll") for (int ks = 0; ks < 4; ++ks) { \
        dst[ks][0] = __builtin_bit_cast(s16x4, __builtin_amdgcn_ds_read_tr16_b64_v4i16((LAS s16x4*)(vb + ((d) * 4 + ks) * 1024))); \
        dst[ks][1] = __builtin_bit_cast(s16x4, __builtin_amdgcn_ds_read_tr16_b64_v4i16((LAS s16x4*)(vb + ((d) * 4 + ks) * 1024 + 512))); } } while (0)
#define AT_VMM(src, d) do { } while (0)
#define AT_VMM2(src, d) do { _Pragma("unroll") for (int ks = 0; ks < 4; ++ks) { \
        const bf16x8 vf = (bf16x8){src[ks][0][0], src[ks][0][1], src[ks][0][2], src[ks][0][3], src[ks][1][0], src[ks][1][1], src[ks][1][2], src[ks][1][3]}; \
        o[d] = __builtin_amdgcn_mfma_f32_32x32x16_bf16(vf, __builtin_bit_cast(bf16x8, pw[ks]), o[d], 0, 0, 0); } } while (0)
#define AT_STEP(B, B2) do { \
        const int t = t_begin + jt; \
        const bool active = (t >= wave_tmin && t <= wave_tmax), more = (jt + 2 < nt); \
        if (more) AT_DMA(t + 2, (B2)); \
        if (active) { \
            const LAS unsigned char* kb = lds + (B) * TBYTES; \
            const LAS unsigned char* vb = lds + (B) * TBYTES + KBYTES + voff; \
            f32x16 p0, p1; \
        _Pragma("unroll") \
            for (int r = 0; r < 16; ++r) { p0[r] = 0.f; p1[r] = 0.f; } \
            { bf16x8 kf[2][2][2]; \
              AT_KRD(kf[0], 0); \
        _Pragma("unroll") \
              for (int g = 0; g < NG; ++g) { \
                  if (g + 1 < NG) AT_KRD(kf[(g + 1) & 1], g + 1); \
                  __builtin_amdgcn_sched_barrier(0); AT_KMM(kf[g & 1], g); __builtin_amdgcn_sched_barrier(0); } } \
            s16x4 va[4][2]; AT_VRD(va, 0); __builtin_amdgcn_sched_barrier(0); \
            if (MODE == 1) { \
                if (t * 64 + 63 > qabs - r32) { \
        _Pragma("unroll") \
                    for (int r = 0; r < 16; ++r) { const int key = t * 64 + crow(r, hi); if (key > qabs) p0[r] = -1e30f; if (key + 32 > qabs) p1[r] = -1e30f; } \
                } \
            } \
            float mx = p0[0]; \
        _Pragma("unroll") \
            for (int r = 1; r < 16; ++r) mx = fmaxf(mx, p0[r]); \
        _Pragma("unroll") \
            for (int r = 0; r < 16; ++r) mx = fmaxf(mx, p1[r]); \
            mx = fmaxf(mx, __shfl_xor(mx, 32)); \
              \
            const float mn = (mx > m_run + 8.0f) ? mx : m_run, alpha = __builtin_amdgcn_exp2f(m_run - mn); m_run = mn; \
            float rs = 0.f; \
        _Pragma("unroll") \
            for (int r = 0; r < 16; ++r) { p0[r] = __builtin_amdgcn_exp2f(p0[r] - mn); p1[r] = __builtin_amdgcn_exp2f(p1[r] - mn); rs += p0[r] + p1[r]; } \
            l_run = l_run * alpha + rs; \
            if (__builtin_amdgcn_ballot_w64(alpha != 1.0f) != 0ull) { \
        _Pragma("unroll") \
                for (int d = 0; d < NDB; ++d) \
        _Pragma("unroll") \
                    for (int r = 0; r < 16; ++r) o[d][r] *= alpha; \
            } \
            u32x4 pw[4]; \
        _Pragma("unroll") \
            for (int e = 0; e < 4; ++e) { pw[0][e] = cvtpk(p0[2 * e], p0[2 * e + 1]); pw[1][e] = cvtpk(p0[8 + 2 * e], p0[8 + 2 * e + 1]); pw[2][e] = cvtpk(p1[2 * e], p1[2 * e + 1]); pw[3][e] = cvtpk(p1[8 + 2 * e], p1[8 + 2 * e + 1]); } \
            { if constexpr (NDB > 1) { s16x4 vc[4][2]; AT_VRD(vc, 1); __builtin_amdgcn_sched_barrier(0); AT_VMM2(va, 0); __builtin_amdgcn_sched_barrier(0); \
                if constexpr (NDB > 2) { AT_VRD(va, 2); __builtin_amdgcn_sched_barrier(0); AT_VMM2(vc, 1); __builtin_amdgcn_sched_barrier(0); \
                  AT_VRD(vc, 3); __builtin_amdgcn_sched_barrier(0); AT_VMM2(va, 2); __builtin_amdgcn_sched_barrier(0); AT_VMM2(vc, 3); } \
                else { AT_VMM2(vc, 1); } } \
              else { AT_VMM2(va, 0); } } \
        } \
        if (more) at_wait_vm<NDMA>(); else at_wait_vm<0>(); \
        AT_BAR(); \
    } while (0)
    if (wid >= 4) __builtin_amdgcn_s_setprio(1);
    for (int jt = 0; jt < nt; ) {
        AT_STEP(0, 2); if (++jt >= nt) break;
        AT_STEP(1, 0); if (++jt >= nt) break;
        AT_STEP(2, 1); ++jt;
    }
#undef AT_STEP
    __builtin_amdgcn_s_setprio(0);
#undef AT_KRD
#undef AT_KMM
#undef AT_VRD
#undef AT_VMM
#undef AT_VMM2
#undef AT_DMA
#undef AT_BAR
    const float lt = l_run + __shfl_xor(l_run, 32);
    const float inv = __builtin_amdgcn_rcpf(lt);
    bf16_t* orow = ow + (size_t)r32 * o_ld;
#pragma unroll
    for (int d = 0; d < NDB; ++d)
#pragma unroll
        for (int j2 = 0; j2 < 2; ++j2) {
            u32x2 P0, P1;
            P0.x = cvtpk(o[d][8 * j2] * inv, o[d][8 * j2 + 1] * inv); P0.y = cvtpk(o[d][8 * j2 + 2] * inv, o[d][8 * j2 + 3] * inv);
            P1.x = cvtpk(o[d][8 * j2 + 4] * inv, o[d][8 * j2 + 5] * inv); P1.y = cvtpk(o[d][8 * j2 + 6] * inv, o[d][8 * j2 + 7] * inv);
            const unsigned sx = hi ? P0.x : P1.x, sy = hi ? P0.y : P1.y;
            const unsigned rx = (unsigned)__shfl_xor((int)sx, 32), ry = (unsigned)__shfl_xor((int)sy, 32);
            u32x4 w;
            if (hi == 0) { w.x = P0.x; w.y = P0.y; w.z = rx; w.w = ry; } else { w.x = rx; w.y = ry; w.z = P1.x; w.w = P1.y; }
            *(u32x4*)(orow + 32 * d + 16 * j2 + 8 * hi) = w;
        }
}


__device__ __forceinline__ void swa_unit(LAS unsigned char* lds, const bf16_t* PROJ, bf16_t* Y, const int* positions, const float* qg, const float* sinks, int b, int n, int kvh) {
    int tid_ = threadIdx.x; asm volatile("" : "+v"(tid_));
    asm volatile("" : "+s"(qg), "+s"(sinks));
    const int tid = tid_, lane = tid & 63, wid = __builtin_amdgcn_readfirstlane(tid >> 6), r32 = lane & 31, hi = lane >> 5, w4 = wid & 3;
    constexpr int SLOT = 16384, KB_ = 8192;
    LAS float* poskf = (LAS float*)(lds + 4 * SLOT);
    const int t_begin = (n == 0) ? 2 : 0;
    const long key0 = (long)b * SEQ + 128 * (n - 1);
    const bf16_t* Kg = PROJ + key0 * INP + C_KA + kvh * 64; const bf16_t* Vg = PROJ + key0 * INP + C_VA + kvh * 64;
    const unsigned lds0 = (unsigned)(size_t)lds;
    { const unsigned kr_ = (unsigned)(lane >> 3), kc_ = ((unsigned)(lane & 7) ^ kr_ ^ (unsigned)((wid >> 1) & 1));
      const unsigned ko = kr_ * (unsigned)INP * 2u + kc_ * 16u, vo = ((unsigned)(lane >> 2) * (unsigned)INP + (unsigned)(lane & 3) * 8u) * 2u;
      for (int t = t_begin; t < 4; ++t) {
          at_glds16((const char*)Kg + ((size_t)(t * 64 + 8 * wid) * INP) * 2 + ko, (unsigned)__builtin_amdgcn_readfirstlane((int)(lds0 + (unsigned)(t * SLOT + wid * 1024))));
          at_glds16((const char*)Vg + (((size_t)(t * 64 + (wid & 3) * 16)) * INP + (wid >> 2) * 32) * 2 + vo, (unsigned)__builtin_amdgcn_readfirstlane((int)(lds0 + (unsigned)(t * SLOT + KB_ + wid * 1024)))); }
      if (tid < 256) poskf[tid] = (n == 0 && tid < 128) ? 0.f : (float)positions[key0 + tid]; }
    unsigned kro[4];
#pragma unroll
    for (int j = 0; j < 4; ++j) kro[j] = (unsigned)((r32 >> 3) * 1024 + (r32 & 7) * 128) + (((unsigned)(2 * j + hi) ^ (unsigned)(r32 & 7) ^ (unsigned)((r32 >> 4) & 1)) * 16u);
    const int voff = ((4 * hi + ((lane & 15) >> 2)) * 64) + (((lane >> 4) & 1) * 32) + ((lane & 3) * 8);
    const size_t tok0 = (size_t)b * SEQ + 128 * n + 32 * w4;
    const float pos_qf = (float)positions[tok0 + r32];
    const int qloc = 32 * w4 + r32;
    const int tlo = (w4 < 2) ? t_begin : (t_begin > 1 ? t_begin : 1), thi = (w4 < 2) ? 2 : 3;
    float sk4[4];
#pragma unroll
    for (int i = 0; i < 4; ++i) sk4[i] = sinks[kvh * 8 + i * 2 + (wid >> 2)];
    bf16x8 qn[4];
    { const bf16_t* qw = PROJ + tok0 * INP + C_QA + (kvh * 8 + (wid >> 2)) * 64;
#pragma unroll
      for (int s = 0; s < 4; ++s) qn[s] = *(const bf16x8*)(qw + (size_t)r32 * INP + 16 * s + 8 * hi); }
#pragma unroll 1
    for (int hp = 0; hp < 4; ++hp) {
        const int head = kvh * 8 + hp * 2 + (wid >> 2);
        bf16x8 qf[4];
#pragma unroll
        for (int s = 0; s < 4; ++s) qf[s] = qn[s];
        if (hp < 3) { const bf16_t* qw = PROJ + tok0 * INP + C_QA + (head + 2) * 64;
#pragma unroll
            for (int s = 0; s < 4; ++s) qn[s] = *(const bf16x8*)(qw + (size_t)r32 * INP + 16 * s + 8 * hi); }
        { const float* qg2 = qg; asm volatile("" : "+s"(qg2)); qseg_norm<0, 4>(qf, qg2, QS_SWA, hi); }
        const float slope2 = __builtin_amdgcn_exp2f(-0.5f * (float)(head + 1)) * LOG2E, sink2 = ((hp == 0) ? sk4[0] : (hp == 1) ? sk4[1] : (hp == 2) ? sk4[2] : sk4[3]) * LOG2E;
        if (hp == 0) { asm volatile("s_waitcnt vmcnt(0) lgkmcnt(0)" ::: "memory"); __builtin_amdgcn_s_barrier(); asm volatile("" ::: "memory"); }
        f32x16 o[2];
#pragma unroll
        for (int d = 0; d < 2; ++d)
#pragma unroll
            for (int r = 0; r < 16; ++r) o[d][r] = 0.f;
        float m_run = sink2, l_run = (hi == 0) ? 1.f : 0.f;
#pragma unroll 1
        for (int t = tlo; t <= thi; ++t) {
            const LAS unsigned char* kb = lds + t * SLOT;
            const bool n0 = (2 * t >= w4) && (2 * t <= w4 + 4), n1 = (2 * t + 1 >= w4) && (2 * t + 1 <= w4 + 4);
            f32x16 p0, p1;
#pragma unroll
            for (int r = 0; r < 16; ++r) { p0[r] = 0.f; p1[r] = 0.f; }
            bf16x8 ka[4][2];
#pragma unroll
            for (int s4 = 0; s4 < 4; ++s4) { ka[s4][0] = *(const LAS bf16x8*)(kb + kro[s4]); ka[s4][1] = *(const LAS bf16x8*)(kb + kro[s4] + 4096); }
            if (n0) {
#pragma unroll
                for (int s4 = 0; s4 < 4; ++s4) p0 = __builtin_amdgcn_mfma_f32_32x32x16_bf16(ka[s4][0], qf[s4], p0, 0, 0, 0); }
            if (n1) {
#pragma unroll
                for (int s4 = 0; s4 < 4; ++s4) p1 = __builtin_amdgcn_mfma_f32_32x32x16_bf16(ka[s4][1], qf[s4], p1, 0, 0, 0); }
            const LAS unsigned char* vb = lds + t * SLOT + KB_ + voff;
            s16x4 va[2][4][2];
#pragma unroll
            for (int d = 0; d < 2; ++d)
#pragma unroll
                for (int ks = 0; ks < 4; ++ks) {
                    va[d][ks][0] = __builtin_bit_cast(s16x4, __builtin_amdgcn_ds_read_tr16_b64_v4i16((LAS s16x4*)(vb + (d * 4 + ks) * 1024)));
                    va[d][ks][1] = __builtin_bit_cast(s16x4, __builtin_amdgcn_ds_read_tr16_b64_v4i16((LAS s16x4*)(vb + (d * 4 + ks) * 1024 + 512))); }
            const int qk0 = 128 + qloc - t * 64 - 4 * hi;
            float mx = -1e30f;
            if (n0) {
#pragma unroll
                for (int r = 0; r < 16; ++r) {
                    const int kl = (r & 3) + 8 * (r >> 2), ki0 = t * 64 + 4 * hi + kl;
                    const float b0 = fmaf(-slope2, fabsf(pos_qf - poskf[ki0]), p0[r]);
                    p0[r] = ((unsigned)(qk0 - kl) < 128u) ? b0 : -1e30f;
                    mx = fmaxf(mx, p0[r]);
                } }
            if (n1) {
#pragma unroll
                for (int r = 0; r < 16; ++r) {
                    const int kl = (r & 3) + 8 * (r >> 2), ki0 = t * 64 + 4 * hi + kl;
                    const float b1 = fmaf(-slope2, fabsf(pos_qf - poskf[ki0 + 32]), p1[r]);
                    p1[r] = ((unsigned)(qk0 - kl - 32) < 128u) ? b1 : -1e30f;
                    mx = fmaxf(mx, p1[r]);
                } }
            mx = fmaxf(mx, __shfl_xor(mx, 32));
            const float mn = (mx > m_run + 8.0f) ? mx : m_run, alpha = __builtin_amdgcn_exp2f(m_run - mn); m_run = mn;
            float rs = 0.f;
            if (n0) {
#pragma unroll
                for (int r = 0; r < 16; ++r) { p0[r] = __builtin_amdgcn_exp2f(p0[r] - mn); rs += p0[r]; } }
            if (n1) {
#pragma unroll
                for (int r = 0; r < 16; ++r) { p1[r] = __builtin_amdgcn_exp2f(p1[r] - mn); rs += p1[r]; } }
            l_run = l_run * alpha + rs;
            if (__builtin_amdgcn_ballot_w64(alpha != 1.0f) != 0ull) {
#pragma unroll
                for (int d = 0; d < 2; ++d)
#pragma unroll
                    for (int r = 0; r < 16; ++r) o[d][r] *= alpha;
            }
            if (n0) {
                u32x4 pw[2];
#pragma unroll
                for (int e = 0; e < 4; ++e) { pw[0][e] = cvtpk(p0[2 * e], p0[2 * e + 1]); pw[1][e] = cvtpk(p0[8 + 2 * e], p0[8 + 2 * e + 1]); }
#pragma unroll
                for (int d = 0; d < 2; ++d)
#pragma unroll
                    for (int ks = 0; ks < 2; ++ks) {
                        const bf16x8 vf = (bf16x8){va[d][ks][0][0], va[d][ks][0][1], va[d][ks][0][2], va[d][ks][0][3], va[d][ks][1][0], va[d][ks][1][1], va[d][ks][1][2], va[d][ks][1][3]};
                        o[d] = __builtin_amdgcn_mfma_f32_32x32x16_bf16(vf, __builtin_bit_cast(bf16x8, pw[ks]), o[d], 0, 0, 0); } }
            if (n1) {
                u32x4 pw[2];
#pragma unroll
                for (int e = 0; e < 4; ++e) { pw[0][e] = cvtpk(p1[2 * e], p1[2 * e + 1]); pw[1][e] = cvtpk(p1[8 + 2 * e], p1[8 + 2 * e + 1]); }
#pragma unroll
                for (int d = 0; d < 2; ++d)
#pragma unroll
                    for (int ks = 2; ks < 4; ++ks) {
                        const bf16x8 vf = (bf16x8){va[d][ks][0][0], va[d][ks][0][1], va[d][ks][0][2], va[d][ks][0][3], va[d][ks][1][0], va[d][ks][1][1], va[d][ks][1][2], va[d][ks][1][3]};
                        o[d] = __builtin_amdgcn_mfma_f32_32x32x16_bf16(vf, __builtin_bit_cast(bf16x8, pw[ks - 2]), o[d], 0, 0, 0); } }
        }
        const float lt = l_run + __shfl_xor(l_run, 32);
        const float inv = __builtin_amdgcn_rcpf(lt);
        bf16_t* orow = Y + (tok0 + r32) * DM + head * 64;
#pragma unroll
        for (int d = 0; d < 2; ++d)
#pragma unroll
            for (int j2 = 0; j2 < 2; ++j2) {
                u32x2 P0, P1;
                P0.x = cvtpk(o[d][8 * j2] * inv, o[d][8 * j2 + 1] * inv); P0.y = cvtpk(o[d][8 * j2 + 2] * inv, o[d][8 * j2 + 3] * inv);
                P1.x = cvtpk(o[d][8 * j2 + 4] * inv, o[d][8 * j2 + 5] * inv); P1.y = cvtpk(o[d][8 * j2 + 6] * inv, o[d][8 * j2 + 7] * inv);
                const unsigned sx = hi ? P0.x : P1.x, sy = hi ? P0.y : P1.y;
                const unsigned rx = (unsigned)__shfl_xor((int)sx, 32), ry = (unsigned)__shfl_xor((int)sy, 32);
                u32x4 w;
                if (hi == 0) { w.x = P0.x; w.y = P0.y; w.z = rx; w.w = ry; } else { w.x = rx; w.y = ry; w.z = P1.x; w.w = P1.y; }
                *(u32x4*)(orow + 32 * d + 16 * j2 + 8 * hi) = w;
            }
    }
    asm volatile("s_waitcnt lgkmcnt(0)" ::: "memory"); __builtin_amdgcn_s_barrier(); asm volatile("" ::: "memory");
}


__device__ __forceinline__ void mem_unit(LAS unsigned char* lds, const bf16_t* PROJ, const bf16_t* KVM, bf16_t* Y, const float* qg, int b, int h, int qq) {
    int tid_ = threadIdx.x; asm volatile("" : "+v"(tid_));
    asm volatile("" : "+s"(qg));
    const int tid = tid_, lane = tid & 63, wid = __builtin_amdgcn_readfirstlane(tid >> 6), r32 = lane & 31, hi = lane >> 5;
    constexpr int SLOT = 32768, KB_ = 16384;
    const bf16_t* Kg = KVM + (size_t)b * MEML * 1024 + h * 128; const bf16_t* Vg = Kg + 512;
    const unsigned lds0 = (unsigned)(size_t)lds;
    { const unsigned kr_ = (unsigned)(lane >> 3), kc_ = ((unsigned)(lane & 7) ^ kr_ ^ (unsigned)((wid >> 1) & 1));
      const unsigned ko = kr_ * 1024u * 2u + kc_ * 16u, vo = ((unsigned)(lane >> 2) * 1024u + (unsigned)(lane & 3) * 8u) * 2u;
      for (int t = 0; t < 4; ++t) {
#pragma unroll
          for (int i = 0; i < 2; ++i) {
              at_glds16((const char*)Kg + ((size_t)(t * 64 + 8 * wid) * 1024 + i * 64) * 2 + ko, (unsigned)__builtin_amdgcn_readfirstlane((int)(lds0 + (unsigned)(t * SLOT + (i * 8 + wid) * 1024))));
              const int p = wid + 8 * i, dblk = p >> 2, ks = p & 3;
              at_glds16((const char*)Vg + (((size_t)(t * 64 + ks * 16)) * 1024 + dblk * 32) * 2 + vo, (unsigned)__builtin_amdgcn_readfirstlane((int)(lds0 + (unsigned)(t * SLOT + KB_ + p * 1024)))); } } }
    unsigned kro[4];
#pragma unroll
    for (int j = 0; j < 4; ++j) kro[j] = (unsigned)((r32 >> 3) * 1024 + (r32 & 7) * 128) + (((unsigned)(2 * j + hi) ^ (unsigned)(r32 & 7) ^ (unsigned)((r32 >> 4) & 1)) * 16u);
    const int voff = ((4 * hi + ((lane & 15) >> 2)) * 64) + (((lane >> 4) & 1) * 32) + ((lane & 3) * 8);
    bf16x8 qn[8];
    { const bf16_t* qw = PROJ + ((size_t)b * SEQ + 256 * (4 * qq) + 32 * wid) * INP + C_QM + h * 128;
#pragma unroll
      for (int s = 0; s < 8; ++s) qn[s] = *(const bf16x8*)(qw + (size_t)r32 * INP + 16 * s + 8 * hi); }
#pragma unroll 1
    for (int pass = 0; pass < 4; ++pass) {
        const size_t tok0 = (size_t)b * SEQ + 256 * (4 * qq + pass) + 32 * wid;
        bf16x8 qf[8];
#pragma unroll
        for (int s = 0; s < 8; ++s) qf[s] = qn[s];
        if (pass < 3) { const bf16_t* qw = PROJ + (tok0 + 256) * INP + C_QM + h * 128;
#pragma unroll
            for (int s = 0; s < 8; ++s) qn[s] = *(const bf16x8*)(qw + (size_t)r32 * INP + 16 * s + 8 * hi); }
        { const float* qg2 = qg; asm volatile("" : "+s"(qg2)); qseg_norm<0, 8>(qf, qg2, QS_MEM, hi); }
        if (pass == 0) { asm volatile("s_waitcnt vmcnt(0) lgkmcnt(0)" ::: "memory"); __builtin_amdgcn_s_barrier(); asm volatile("" ::: "memory"); }
        f32x16 o[4];
#pragma unroll
        for (int d = 0; d < 4; ++d)
#pragma unroll
            for (int r = 0; r < 16; ++r) o[d][r] = 0.f;
        float m_run = -1e30f, l_run = 0.f;
#pragma unroll 1
        for (int t = 0; t < 4; ++t) {
            const LAS unsigned char* kb = lds + t * SLOT;
            const LAS unsigned char* vb = lds + t * SLOT + KB_ + voff;
            f32x16 p0, p1;
#pragma unroll
            for (int r = 0; r < 16; ++r) { p0[r] = 0.f; p1[r] = 0.f; }
            { bf16x8 kf[2][2][2];
#pragma unroll
              for (int s4 = 0; s4 < 2; ++s4) { kf[0][s4][0] = *(const LAS bf16x8*)(kb + kro[s4]); kf[0][s4][1] = *(const LAS bf16x8*)(kb + kro[s4] + 4096); }
#pragma unroll
              for (int g = 0; g < 4; ++g) {
                  if (g + 1 < 4) {
#pragma unroll
                      for (int s4 = 0; s4 < 2; ++s4) { const int s_ = (g + 1) * 2 + s4; kf[(g + 1) & 1][s4][0] = *(const LAS bf16x8*)(kb + kro[s_ & 3] + (s_ >> 2) * 8192); kf[(g + 1) & 1][s4][1] = *(const LAS bf16x8*)(kb + kro[s_ & 3] + (s_ >> 2) * 8192 + 4096); } }
                  __builtin_amdgcn_sched_barrier(0);
#pragma unroll
                  for (int s4 = 0; s4 < 2; ++s4) { p0 = __builtin_amdgcn_mfma_f32_32x32x16_bf16(kf[g & 1][s4][0], qf[g * 2 + s4], p0, 0, 0, 0); p1 = __builtin_amdgcn_mfma_f32_32x32x16_bf16(kf[g & 1][s4][1], qf[g * 2 + s4], p1, 0, 0, 0); }
                  __builtin_amdgcn_sched_barrier(0); } }
            float mx = p0[0];
#pragma unroll
            for (int r = 1; r < 16; ++r) mx = fmaxf(mx, p0[r]);
#pragma unroll
            for (int r = 0; r < 16; ++r) mx = fmaxf(mx, p1[r]);
            mx = fmaxf(mx, __shfl_xor(mx, 32));
            const float mn = (mx > m_run + 8.0f) ? mx : m_run, alpha = __builtin_amdgcn_exp2f(m_run - mn); m_run = mn;
            float rs = 0.f;
#pragma unroll
            for (int r = 0; r < 16; ++r) { p0[r] = __builtin_amdgcn_exp2f(p0[r] - mn); p1[r] = __builtin_amdgcn_exp2f(p1[r] - mn); rs += p0[r] + p1[r]; }
            l_run = l_run * alpha + rs;
            if (__builtin_amdgcn_ballot_w64(alpha != 1.0f) != 0ull) {
#pragma unroll
                for (int d = 0; d < 4; ++d)
#pragma unroll
                    for (int r = 0; r < 16; ++r) o[d][r] *= alpha;
            }
            u32x4 pw[4];
#pragma unroll
            for (int e = 0; e < 4; ++e) { pw[0][e] = cvtpk(p0[2 * e], p0[2 * e + 1]); pw[1][e] = cvtpk(p0[8 + 2 * e], p0[8 + 2 * e + 1]); pw[2][e] = cvtpk(p1[2 * e], p1[2 * e + 1]); pw[3][e] = cvtpk(p1[8 + 2 * e], p1[8 + 2 * e + 1]); }
#pragma unroll
            for (int d = 0; d < 4; ++d) {
                s16x4 va[4][2];
#pragma unroll
                for (int ks = 0; ks < 4; ++ks) {
                    va[ks][0] = __builtin_bit_cast(s16x4, __builtin_amdgcn_ds_read_tr16_b64_v4i16((LAS s16x4*)(vb + (d * 4 + ks) * 1024)));
                    va[ks][1] = __builtin_bit_cast(s16x4, __builtin_amdgcn_ds_read_tr16_b64_v4i16((LAS s16x4*)(vb + (d * 4 + ks) * 1024 + 512))); }
#pragma unroll
                for (int ks = 0; ks < 4; ++ks) {
                    const bf16x8 vf = (bf16x8){va[ks][0][0], va[ks][0][1], va[ks][0][2], va[ks][0][3], va[ks][1][0], va[ks][1][1], va[ks][1][2], va[ks][1][3]};
                    o[d] = __builtin_amdgcn_mfma_f32_32x32x16_bf16(vf, __builtin_bit_cast(bf16x8, pw[ks]), o[d], 0, 0, 0); }
                __builtin_amdgcn_sched_barrier(0); }
        }
        const float lt = l_run + __shfl_xor(l_run, 32);
        const float inv = __builtin_amdgcn_rcpf(lt);
        bf16_t* orow = Y + (tok0 + r32) * DM + 1536 + h * 128;
#pragma unroll
        for (int d = 0; d < 4; ++d)
#pragma unroll
            for (int j2 = 0; j2 < 2; ++j2) {
                u32x2 P0, P1;
                P0.x = cvtpk(o[d][8 * j2] * inv, o[d][8 * j2 + 1] * inv); P0.y = cvtpk(o[d][8 * j2 + 2] * inv, o[d][8 * j2 + 3] * inv);
                P1.x = cvtpk(o[d][8 * j2 + 4] * inv, o[d][8 * j2 + 5] * inv); P1.y = cvtpk(o[d][8 * j2 + 6] * inv, o[d][8 * j2 + 7] * inv);
                const unsigned sx = hi ? P0.x : P1.x, sy = hi ? P0.y : P1.y;
                const unsigned rx = (unsigned)__shfl_xor((int)sx, 32), ry = (unsigned)__shfl_xor((int)sy, 32);
                u32x4 w;
                if (hi == 0) { w.x = P0.x; w.y = P0.y; w.z = rx; w.w = ry; } else { w.x = rx; w.y = ry; w.z = P1.x; w.w = P1.y; }
                *(u32x4*)(orow + 32 * d + 16 * j2 + 8 * hi) = w;
            }
    }
    asm volatile("s_waitcnt lgkmcnt(0)" ::: "memory"); __builtin_amdgcn_s_barrier(); asm volatile("" ::: "memory");
}

constexpr int NPH = 9;
__global__ void __launch_bounds__(512, 2) fwd_kernel(Args args) {
    extern __shared__ __attribute__((aligned(16))) unsigned char lds_raw[];
    LAS unsigned char* lds = (LAS unsigned char*)lds_raw;
    const int tid = threadIdx.x, lane = tid & 63, wave = __builtin_amdgcn_readfirstlane(tid >> 6);
    const int G = gridDim.x, bx = blockIdx.x;
    const int gw = bx * 8 + wave, NGW = G * 8;
    unsigned char* ws = args.ws;
    const float* x = (const float*)args.in[0]; const float* mem = (const float*)args.in[1]; const int* positions = (const int*)args.in[2];
    const float* attn_norm_g = (const float*)args.in[3]; const float* w_in = (const float*)args.in[4];
    const float* swa_q_norm_g = (const float*)args.in[5]; const float* swa_k_norm_g = (const float*)args.in[6]; const float* swa_sinks = (const float*)args.in[7];
    const float* mla_cq_norm_g = (const float*)args.in[8]; const float* mla_ckv_norm_g = (const float*)args.in[9];
    const float* w_uq = (const float*)args.in[10]; const float* w_ukv = (const float*)args.in[11];
    const float* mla_qn_norm_g = (const float*)args.in[12]; const float* mla_qr_norm_g = (const float*)args.in[13];
    const float* mla_kn_norm_g = (const float*)args.in[14]; const float* mla_kr_norm_g = (const float*)args.in[15];
    const float* mem_norm_g = (const float*)args.in[16]; const float* w_mem_kv = (const float*)args.in[17];
    const float* mem_q_norm_g = (const float*)args.in[18]; const float* mem_k_norm_g = (const float*)args.in[19];
    const float* w_out = (const float*)args.in[20]; const float* ffn_norm_g = (const float*)args.in[21];
    const float* w_gate = (const float*)args.in[22]; const float* w_up = (const float*)args.in[23]; const float* w_down = (const float*)args.in[24];
    float* out = args.out;
    unsigned* ctl = (unsigned*)(ws + WS_CTL); float* ssq = (float*)(ws + WS_SSQ); float* ssq_cq = ssq + MTOK; float* ssq_ckv = ssq + 2 * MTOK; float* xrms = (float*)(ws + WS_XRMS); float* ginv = (float*)(ws + WS_GINV);
    bf16_t* WIN = (bf16_t*)(ws + WS_WIN); bf16_t* WUQKV = (bf16_t*)(ws + WS_WUQKV); bf16_t* WMEM = (bf16_t*)(ws + WS_WMEM); bf16_t* WOUT = (bf16_t*)(ws + WS_WOUT);
    bf16_t* WGU = (bf16_t*)(ws + WS_WGU); bf16_t* WDN = (bf16_t*)(ws + WS_WDN);
    bf16_t* XN = (bf16_t*)(ws + WS_XN); bf16_t* HB = XN; bf16_t* Y = (bf16_t*)(ws + WS_Y); bf16_t* MEMN = (bf16_t*)(ws + WS_MEMN); bf16_t* KVM = (bf16_t*)(ws + WS_KVM);
    float* KVMP = (float*)(ws + WS_KVMP); bf16_t* PROJ = (bf16_t*)(ws + WS_PROJ); bf16_t* QKVB = (bf16_t*)(ws + WS_QKVB); bf16_t* ACT = (bf16_t*)(ws + WS_ACT);
    const int lo = args.lo, hi = args.hi;
    cg::grid_group grid = cg::this_grid();
    volatile LAS unsigned* MISC = (volatile LAS unsigned*)(lds + MISC_OFF);
    if (tid < 64) MISC[tid] = 0u;
    __syncthreads();
    XcdBarrier bar; bar.bar = ctl + CW_BAR; bar.x = 0; bar.st = MISC + 8;
    if (hi - lo > 1) bar = xcd_barrier_post(ctl + CW_BAR, MISC + 8);
    if (hi > 1000) grid.sync();
#define IN(k) (lo <= (k) && (k) < hi)
#define SEAM(k) do { if ((k) + 1 < hi) xcd_barrier(bar); } while (0)

    if (IN(0)) {
        LAS unsigned* scr = (LAS unsigned*)(lds + wave * 16384);
        constexpr int I_IN = (DM / 64) * (INW / 64), I_UQ = (512 / 64) * (768 / 64), I_UKV = (512 / 64) * (1024 / 64), I_MEM = (DM / 64) * (1024 / 64), I_OUT = (DM / 64) * (DM / 64),
                      I_G = (DM / 64) * (DFF / 64), I_DN = (DFF / 64) * (DM / 64);
        constexpr int NITEMS = I_IN + I_UQ + I_UKV + I_MEM;
        for (int it = gw; it < NITEMS; it += NGW) {
            int r = it;
            if (r < I_IN) { p0_transpose_item(w_in, DM, INW, WIN, 3, nullptr, scr, r, lane); continue; } r -= I_IN;
            if (r < I_UQ) { p0_transpose_item(w_uq, 512, 768, WUQKV, 0, mla_cq_norm_g, scr, r, lane); continue; } r -= I_UQ;
            if (r < I_UKV) { p0_transpose_item(w_ukv, 512, 1024, WUQKV + (size_t)768 * 512, 0, mla_ckv_norm_g, scr, r, lane); continue; } r -= I_UKV;
            p0_transpose_item(w_mem_kv, DM, 1024, WMEM, 0, nullptr, scr, r, lane, 512);
        }
        for (int i = bx * 512 + tid; i < DM; i += G * 512) ginv[i] = 1.0f / attn_norm_g[i];
        { u32x4* z = (u32x4*)(WIN + (size_t)INW * DM); const int nz = (INP - INW) * DM * 2 / 16; for (int i = bx * 512 + tid; i < nz; i += G * 512) z[i] = (u32x4){0u, 0u, 0u, 0u}; }
        for (int m = 2 * gw; m < MTOK; m += 2 * NGW) rms_row2_to_bf16(x + (size_t)m * DM, x + (size_t)(m + 1) * DM, attn_norm_g, XN + (size_t)m * DM, XN + (size_t)(m + 1) * DM, lane, xrms + m);
        for (int m = 2 * gw; m < MMEM; m += 2 * NGW) rms_row2_to_bf16(mem + (size_t)m * DM, mem + (size_t)(m + 1) * DM, mem_norm_g, MEMN + (size_t)m * INP, MEMN + (size_t)(m + 1) * INP, lane);
        SEAM(0);
    }

    if (IN(1)) {
        pg8::Gemm g{XN, WIN, DM, DM, DM, 1 << 30, 0}; pg8::StaticOrder S; S.init(MTOK, INP, G, bx);
        pg8::EpiInProj E{PROJ, ssq_cq, ssq_ckv, swa_k_norm_g, mla_kr_norm_g, positions};
        pg8::gemm_phase<pg8::EpiInProj, pg8::StaticOrder>(lds, g, S, E);
        SEAM(1);
    }

    if (IN(3)) {
        pg8::Gemm g{PROJ + C_CQ, WUQKV, INP, 512, 512, 3, 512}; pg8::UpMemOrder S; S.init(MTOK, NQKV, G, bx, MEMN, WMEM);
        pg8::EpiUpProj E{QKVB, ssq_cq, ssq_ckv, KVMP, (LAS float*)(lds + MISC_OFF + 4096), mla_kn_norm_g};
        pg8::gemm_phase<pg8::EpiUpProj, pg8::UpMemOrder>(lds, g, S, E);
        SEAM(3);
    }

    if (IN(4)) {
        for (int t = gw; t < MMEM; t += NGW) {
#pragma unroll
            for (int part = 0; part < 2; ++part) { const int col = part * 512 + 8 * lane; float f[8];
#pragma unroll
                for (int i = 0; i < 8; ++i) f[i] = 0.f;
#pragma unroll
                for (int ks = 0; ks < 4; ++ks) { const float* p = KVMP + ((size_t)ks * MMEM + t) * 1024 + col; const f32x4 a = *(const f32x4*)p, b = *(const f32x4*)(p + 4);
                    f[0] += a[0]; f[1] += a[1]; f[2] += a[2]; f[3] += a[3]; f[4] += b[0]; f[5] += b[1]; f[6] += b[2]; f[7] += b[3]; }
                if (part == 0) { float ss = 0.f;
#pragma unroll
                    for (int i = 0; i < 8; ++i) ss += f[i] * f[i];
                    const float rstd = 1.0f / sqrtf(group_sum<16>(ss) * (1.0f / 128) + EPS);
#pragma unroll
                    for (int i = 0; i < 8; ++i) f[i] = f[i] * rstd * mem_k_norm_g[8 * (lane & 15) + i]; }
                *(u32x4*)(KVM + (size_t)t * 1024 + col) = pack8(f); }
        }
        SEAM(4);
    }

    if (IN(5)) {
        LAS unsigned* uq = (LAS unsigned*)(lds + MISC_OFF);
        unsigned pref = 0u; bool have_pref = false;
        for (;;) {
            if (tid == 0) uq[0] = have_pref ? pref : atomicAdd(ctl, 1u);
            __syncthreads();
            const int u = __builtin_amdgcn_readfirstlane((int)uq[0]) + args.att_lo;
            __syncthreads();
            if (u >= args.att_hi) break;
            have_pref = false;
            const int r32 = lane & 31;
            if (u < N_MLA_UNITS) {
                const int qb = 15 - (u >> 4), bh = u & 15, b = bh >> 2, h = bh & 3;
                const size_t tok0 = (size_t)b * SEQ + 256 * qb + 32 * wave;
                const int qabs = 256 * qb + 32 * wave + r32;
                attn_unit<128, 64, 128, 1>(lds, QKVB + tok0 * NQKV + h * 192, NQKV, QKVB + (size_t)b * SEQ * NQKV + 768 + h * 256, NQKV, PROJ + (size_t)b * SEQ * INP + C_KR, INP,
                                           QKVB + (size_t)b * SEQ * NQKV + 768 + h * 256 + 128, NQKV, Y + tok0 * DM + 1024 + h * 128, DM, 0, 4 * qb + 4,
                                           qabs, (256 * qb + 32 * wave + 31) >> 6, 0, 0.f, 0.f, positions[tok0 + r32], positions, false, mla_qn_norm_g, mla_qr_norm_g);
            } else if (u < N_MLA_UNITS + N_MEM_UNITS) {
                const int v = u - N_MLA_UNITS, qq = v & 3, bh = v >> 2, b = bh >> 2, h = bh & 3;
                mem_unit(lds, PROJ, KVM, Y, mem_q_norm_g, b, h, qq);
            } else if (u >= N_ATT_UNITS) {
                if (tid == 0) pref = atomicAdd(ctl, 1u);
                have_pref = true;
                LAS unsigned* scr = (LAS unsigned*)(lds + wave * 16384);
                int lane2 = lane; asm volatile("" : "+v"(lane2));
                int r = (u - N_ATT_UNITS) * 8 + wave;
                const float* W; bf16_t* WT; int K_, N_, mode; const float* ksc = nullptr;
                if (r < CV_OUT) { W = w_out; WT = WOUT; K_ = DM; N_ = DM; mode = 0; }
                else if ((r -= CV_OUT) < CV_G) { W = w_gate; WT = WGU; K_ = DM; N_ = DFF; mode = 1; ksc = ffn_norm_g; }
                else if ((r -= CV_G) < CV_G) { W = w_up; WT = WGU; K_ = DM; N_ = DFF; mode = 2; ksc = ffn_norm_g; }
                else { r -= CV_G; W = w_down; WT = WDN; K_ = DFF; N_ = DM; mode = 0; }
                p0_transpose_item(W, K_, N_, WT, mode, ksc, scr, r, lane2);
            } else {
                const int v = u - N_MLA_UNITS - N_MEM_UNITS, kvh = v & 1, n = (v >> 1) & 31, b = v >> 6;
                swa_unit(lds, PROJ, Y, positions, swa_q_norm_g, swa_sinks, b, n, kvh);
            }
        }
        SEAM(5);
    }

    if (IN(6)) {
        pg8::Gemm g{Y, WOUT, DM, DM, DM, 1 << 30, 0}; pg8::StaticOrder S; S.init(MTOK, DM, G, bx);
        pg8::EpiOutProj E{XN, xrms, ginv, HB, ssq};
        pg8::gemm_phase<pg8::EpiOutProj, pg8::StaticOrder>(lds, g, S, E);
        SEAM(6);
    }

    if (IN(7)) {
        pg8::Gemm g{HB, WGU, DM, DM, DM, 1 << 30, 0}; pg8::StaticOrder S; S.init(MTOK, 2 * DFF, G, bx);
        pg8::EpiSwiGLU E{ACT, ssq};
        pg8::gemm_phase<pg8::EpiSwiGLU, pg8::StaticOrder>(lds, g, S, E);
        SEAM(7);
    }

    if (IN(8)) {
        pg8::Gemm g{ACT, WDN, DFF, DFF, DFF, 1 << 30, 0}; pg8::StaticOrder S; S.init(MTOK, DM, G, bx);
        pg8::EpiDown E{out, HB};
        pg8::gemm_phase<pg8::EpiDown, pg8::StaticOrder>(lds, g, S, E);
    }
#undef IN
#undef SEAM
}

extern "C" void kernel_launch(void* const* d_in, const int* in_sizes, int n_in, void* d_out, int out_size, void* d_ws, size_t ws_size, hipStream_t stream) {
    static int grid = 0;
    if (grid == 0) {
        if (n_in != 25 || out_size != MTOK * DM || ws_size < WS_END) { fprintf(stderr, "kernel_launch: unexpected shapes (n_in %d, out %d, ws %zu < %zu)\n", n_in, out_size, ws_size, (size_t)WS_END); grid = -1; return; }
        int dev = 0, cus = 0, per_cu = 0;
        hipGetDevice(&dev); hipDeviceGetAttribute(&cus, hipDeviceAttributeMultiprocessorCount, dev);
        if (hipFuncSetAttribute((const void*)fwd_kernel, hipFuncAttributeMaxDynamicSharedMemorySize, LDS_BYTES) != hipSuccess) { fprintf(stderr, "kernel_launch: hipFuncSetAttribute failed\n"); grid = -1; return; }
        if (hipOccupancyMaxActiveBlocksPerMultiprocessor(&per_cu, (const void*)fwd_kernel, 512, LDS_BYTES) != hipSuccess || per_cu < 1) { fprintf(stderr, "kernel_launch: occupancy query says %d\n", per_cu); per_cu = 1; }
        (void)hipGetLastError();
        grid = cus;
        if (grid < 32) grid = 32;
    }
    if (grid < 0) return;
    if (hipMemsetAsync((char*)d_ws + WS_CTL, 0, CTL_ZERO_BYTES, stream) != hipSuccess) { fprintf(stderr, "kernel_launch: hipMemsetAsync failed\n"); return; }
    Args a{};
    for (int i = 0; i < 25; ++i) a.in[i] = d_in[i];
    a.out = (float*)d_out; a.ws = (unsigned char*)d_ws; a.att_lo = 0; a.att_hi = N_QUEUE_UNITS;
#if N_LAUNCHES == 1
    a.lo = 0; a.hi = NPH;
    void* kargs[] = {&a};
    hipError_t e = hipLaunchCooperativeKernel((const void*)fwd_kernel, dim3(grid), dim3(512), kargs, LDS_BYTES, stream);
    if (e != hipSuccess) fprintf(stderr, "kernel_launch: cooperative launch failed: %s (grid %d)\n", hipGetErrorString(e), grid);
#else
    for (int p = 0; p < NPH; ++p) {
        a.lo = p; a.hi = p + 1;
        hipLaunchKernelGGL(fwd_kernel, dim3(grid), dim3(512), LDS_BYTES, stream, a);
#ifdef PROBE_REPEAT
        if (p == PROBE_REPEAT) { Args a2 = a;
#ifdef PROBE_ATT_LO
            a2.att_lo = PROBE_ATT_LO; a2.att_hi = PROBE_ATT_HI;
#endif
            for (int rep = 0; rep < PROBE_NREP; ++rep) { (void)hipMemsetAsync(d_ws, 0, 256, stream); hipLaunchKernelGGL(fwd_kernel, dim3(grid), dim3(512), LDS_BYTES, stream, a2); } }
#endif
    }
#endif
}
```

```cpp
#include <hip/hip_runtime.h>
#include <hip/hip_cooperative_groups.h>
#include <cstdio>
#include <cstdint>
namespace cg = cooperative_groups;

#ifndef N_LAUNCHES
#define N_LAUNCHES 1
#endif

#define LAS __attribute__((address_space(3)))
typedef unsigned short bf16_t;
typedef short bf16x8 __attribute__((ext_vector_type(8)));
typedef short s16x4 __attribute__((ext_vector_type(4)));
typedef float f32x4 __attribute__((ext_vector_type(4)));
typedef float f32x16 __attribute__((ext_vector_type(16)));
typedef unsigned u32x4 __attribute__((ext_vector_type(4)));
typedef unsigned u32x2 __attribute__((ext_vector_type(2)));
typedef float f32x2_t __attribute__((ext_vector_type(2)));
typedef __bf16 bf16x2_t __attribute__((ext_vector_type(2)));

constexpr int BATCH = 4, SEQ = 4096, MTOK = BATCH * SEQ, DM = 2048, MEML = 256, MMEM = BATCH * MEML;
constexpr int INW = 2880, INP = 3072, DFF = 5632;
constexpr int C_QA = 0, C_KA = 1024, C_VA = 1152, C_CQ = 1280, C_CKV = 1792, C_KR = 2304, C_QM = 2368;
constexpr int NQKV = 1792;
constexpr float EPS = 1e-6f;
constexpr float LOG2E = 1.4426950408889634f;
constexpr float QS_SWA = 0.125f * LOG2E;
constexpr float QS_MLA = 0.07216878364870322f * LOG2E;
constexpr float QS_MEM = 0.08838834764831845f * LOG2E;

constexpr size_t al256(size_t x) { return (x + 255) & ~(size_t)255; }
constexpr size_t WS_CTL = 0;
constexpr size_t WS_SSQ = 32768;
constexpr size_t CTL_ZERO_BYTES = WS_SSQ + (size_t)3 * MTOK * 4;
constexpr int CW_BAR = 4096;
constexpr size_t WS_XRMS = al256(WS_SSQ + (size_t)3 * MTOK * 4);
constexpr size_t WS_GINV = WS_XRMS + (size_t)MTOK * 4;
constexpr size_t WS_WIN = al256(WS_GINV + (size_t)DM * 4);
constexpr size_t WS_WUQKV = WS_WIN + (size_t)INP * DM * 2;
constexpr size_t WS_WMEM = WS_WUQKV + (size_t)NQKV * 512 * 2;
constexpr size_t WS_WOUT = WS_WMEM + (size_t)1024 * DM * 2;
constexpr size_t WS_WGU = WS_WOUT + (size_t)DM * DM * 2;
constexpr size_t WS_WDN = WS_WGU + (size_t)2 * DFF * DM * 2;
constexpr size_t WS_XN = WS_WDN + (size_t)DM * DFF * 2;
constexpr size_t WS_Y = WS_XN + (size_t)MTOK * DM * 2;
constexpr size_t WS_MEMN = WS_Y + (size_t)MTOK * DM * 2;
constexpr size_t WS_KVM = WS_MEMN + (size_t)MMEM * INP * 2;
constexpr size_t WS_KVMP = WS_KVM + (size_t)MMEM * 1024 * 2;
constexpr size_t WS_BIG = WS_KVMP + (size_t)4 * MMEM * 1024 * 4;
constexpr size_t WS_PROJ = WS_BIG;
constexpr size_t WS_QKVB = WS_PROJ + (size_t)MTOK * INP * 2;
constexpr size_t WS_ACT = WS_BIG;
constexpr size_t WS_END1 = WS_QKVB + (size_t)MTOK * NQKV * 2, WS_END2 = WS_ACT + (size_t)MTOK * DFF * 2;
constexpr size_t WS_END = WS_END1 > WS_END2 ? WS_END1 : WS_END2;
static_assert(WS_END <= (size_t)512 * 1024 * 1024, "workspace map exceeds 512 MiB");

constexpr int RING_BYTES = 131072;
constexpr int MISC_OFF = RING_BYTES;
constexpr int LDS_BYTES = 147456;

__device__ __forceinline__ unsigned cvtpk(float lo, float hi) { f32x2_t v = {lo, hi}; bf16x2_t b = __builtin_convertvector(v, bf16x2_t); return __builtin_bit_cast(unsigned, b); }
__device__ __forceinline__ float bflo(unsigned w) { return __uint_as_float(w << 16); }
__device__ __forceinline__ float bfhi(unsigned w) { return __uint_as_float(w & 0xffff0000u); }
__device__ __forceinline__ float bf1(bf16_t v) { return __uint_as_float(((unsigned)v) << 16); }
__device__ __forceinline__ void unpack8(const u32x4 w, float (&f)[8]) {
    f[0] = bflo(w.x); f[1] = bfhi(w.x); f[2] = bflo(w.y); f[3] = bfhi(w.y); f[4] = bflo(w.z); f[5] = bfhi(w.z); f[6] = bflo(w.w); f[7] = bfhi(w.w); }
__device__ __forceinline__ u32x4 pack8(const float (&f)[8]) { u32x4 w; w.x = cvtpk(f[0], f[1]); w.y = cvtpk(f[2], f[3]); w.z = cvtpk(f[4], f[5]); w.w = cvtpk(f[6], f[7]); return w; }
template <int W> __device__ __forceinline__ float group_sum(float v) {
#pragma unroll
    for (int o = 1; o < W; o <<= 1) v += __shfl_xor(v, o);
    return v; }

__device__ __forceinline__ void rope_cs(int pos, int i, float& c, float& s) {
    const float inv = __builtin_amdgcn_exp2f(-(float)i * (13.287712379549449f / 32.0f));
    const float ang = (float)pos * inv;
    const float n = rintf(ang * 0.15915494309189535f);
    float r = fmaf(-n, 6.28125f, ang); r = fmaf(-n, 1.9353071795864769e-3f, r);
    const float rev = r * 0.15915494309189535f;
    s = __builtin_amdgcn_sinf(rev); c = __builtin_amdgcn_cosf(rev);
}


namespace pg8 {
constexpr int BM = 256, BK = 64, HALF = 128, HTB = HALF * BK * 2, STAGE_BYTES = 8 * HTB, NXCD = 8, WGM = 8;
__host__ __device__ __forceinline__ int lds_byte(int r, int c) { const int st = (r >> 4) * 2 + (c >> 5), rr = r & 15, cc = c & 31, ob = rr * 64 + cc * 2; return st * 1024 + (ob ^ (((ob >> 9) & 1) << 5)); }
__host__ __device__ __forceinline__ void stage_rc(int b, int& R, int& C) { const int st = b / 1024, sb = b % 1024, swz = sb ^ (((sb >> 9) & 1) << 5); R = (st >> 1) * 16 + swz / 64; C = (st & 1) * 32 + (swz % 64) / 2; }
__host__ __device__ __forceinline__ int perm32(int rho) { const int n = rho >> 4, i = rho & 15; return 8 * (i >> 2) + 4 * n + (i & 3); }

struct Unit { int pm, pn, kind, ks; };
struct Gemm { const bf16_t* A; const bf16_t* Bt; int lda, ldb, K, a_split_pn, a_split_off; };

struct StaticOrder {
    int nM, nN, nwg, G, c;
    __device__ void init(int M, int N, int G_, int c_) { nM = M / BM; nN = N / BM; nwg = nM * nN; G = G_; c = c_; }
    __device__ bool next(int i, Unit& u) const {
        const long L = (long)i * G + c; if (L >= nwg) return false;
        int wgid = (int)L; { const int q = nwg / NXCD, r = nwg % NXCD, xcd = wgid % NXCD, off = wgid / NXCD; wgid = (xcd < r ? xcd * (q + 1) : r * (q + 1) + (xcd - r) * q) + off; }
        const int nig = WGM * nN, gid = wgid / nig, fm = gid * WGM, gsz = (nM - fm) < WGM ? (nM - fm) : WGM;
        u.pm = fm + ((wgid % nig) % gsz); u.pn = (wgid % nig) / gsz; u.kind = 0; u.ks = 0; return true;
    }
    __device__ __forceinline__ void ptrs(const Gemm& g, const Unit& u, const char*& a, const char*& b) const {
        a = (const char*)g.A + (size_t)u.pm * (BM * 2) * g.lda + (u.pn >= g.a_split_pn ? (size_t)g.a_split_off * 2 : (size_t)0);
        b = (const char*)g.Bt + (size_t)u.pn * (BM * 2) * g.ldb;
    }
};
struct UpMemOrder {
    StaticOrder base; const bf16_t* memn; const bf16_t* wmems;
    __device__ void init(int M, int N, int G_, int c_, const bf16_t* memn_, const bf16_t* wmems_) { base.init(M, N, G_, c_); memn = memn_; wmems = wmems_; }
    __device__ bool next(int i, Unit& u) const {
        if (base.next(i, u)) return true;
        const long L = (long)i * base.G + base.c - base.nwg; if (L >= 64) return false;
        const int q = (int)L, tile = q >> 2; u.kind = 1; u.ks = q & 3; u.pm = tile >> 2; u.pn = tile & 3; return true;
    }
    __device__ __forceinline__ void ptrs(const Gemm& g, const Unit& u, const char*& a, const char*& b) const {
        if (u.kind == 0) { base.ptrs(g, u, a, b); return; }
        a = (const char*)memn + ((size_t)u.pm * BM * g.lda + (size_t)u.ks * 512) * 2;
        b = (const char*)wmems + ((size_t)u.ks * 1024 * 512 + (size_t)u.pn * BM * 512) * 2;
    }
};

struct EpiBf16 {
    static constexpr bool PERM = true; static constexpr int NPRE = 0;
    bf16_t* O; int ldc;
    __device__ __forceinline__ void operator()(const f32x4 (&acc)[2][2][4][2], const Unit& u, int wr, int wc, int fr, int fq) const {
        const int row0 = u.pm * BM + wr * 64 + fr, col0 = u.pn * BM + wc * 32 + 8 * fq;
#pragma unroll
        for (int ai = 0; ai < 2; ++ai)
#pragma unroll
            for (int m = 0; m < 4; ++m) { bf16_t* rowp = O + (size_t)(row0 + ai * HALF + m * 16) * ldc + col0;
#pragma unroll
                for (int bj = 0; bj < 2; ++bj) { const f32x4 v0 = acc[ai][bj][m][0], v1 = acc[ai][bj][m][1];
                    u32x4 w; w.x = cvtpk(v0[0], v0[1]); w.y = cvtpk(v0[2], v0[3]); w.z = cvtpk(v1[0], v1[1]); w.w = cvtpk(v1[2], v1[3]);
                    *(u32x4*)(rowp + bj * HALF) = w; } }
    }
};
struct EpiInProj {
    static constexpr bool PERM = true; static constexpr int NPRE = 0;
    bf16_t* O; float* ssq_cq; float* ssq_ckv; const float* g_ka; const float* g_kr; const int* positions;
    __device__ __forceinline__ void operator()(const f32x4 (&acc)[2][2][4][2], const Unit& u, int wr, int wc, int fr, int fq) const {
        const int row0 = u.pm * BM + wr * 64 + fr;
        const int pn = u.pn;
        if (pn == 4 || pn == 9) {
            const int cbase = pn * BM + 64 * wc + 8 * fq;
            const bool norm = (pn == 4) ? (wc < 2) : (wc == 0);
            const float* gg = (pn == 4) ? g_ka : g_kr;
            float gv[2][8];
#pragma unroll
            for (int bj = 0; bj < 2; ++bj)
#pragma unroll
                for (int i = 0; i < 8; ++i) gv[bj][i] = norm ? gg[32 * bj + 8 * fq + i] : 1.0f;
#pragma unroll
            for (int ai = 0; ai < 2; ++ai)
#pragma unroll
                for (int m = 0; m < 4; ++m) { const int row = row0 + ai * HALF + m * 16;
                    float v[2][8];
#pragma unroll
                    for (int bj = 0; bj < 2; ++bj)
#pragma unroll
                        for (int n = 0; n < 2; ++n)
#pragma unroll
                            for (int e = 0; e < 4; ++e) v[bj][4 * n + e] = acc[ai][bj][m][n][e];
                    {
                        float ss = 0.f;
#pragma unroll
                        for (int bj = 0; bj < 2; ++bj)
#pragma unroll
                            for (int i = 0; i < 8; ++i) ss += v[bj][i] * v[bj][i];
                        ss += __shfl_xor(ss, 16); ss += __shfl_xor(ss, 32);
                        const float rstd = norm ? __builtin_amdgcn_rsqf(ss * (1.0f / 64) + EPS) : 1.0f;
#pragma unroll
                        for (int bj = 0; bj < 2; ++bj)
#pragma unroll
                            for (int i = 0; i < 8; ++i) v[bj][i] *= rstd * gv[bj][i];
                        const bool rope = norm && (pn == 9);
                        const int pos = positions[row];
#pragma unroll
                        for (int i = 0; i < 8; ++i) { float c_, s_; rope_cs(pos, 8 * fq + i, c_, s_); if (!rope) { c_ = 1.0f; s_ = 0.0f; } const float x1 = v[0][i], x2 = v[1][i]; v[0][i] = x1 * c_ - x2 * s_; v[1][i] = x1 * s_ + x2 * c_; }
                    }
#pragma unroll
                    for (int bj = 0; bj < 2; ++bj) *(u32x4*)(O + (size_t)row * INP + cbase + 32 * bj) = pack8(v[bj]);
                }
            return;
        }
        const int col0 = pn * BM + wc * 32 + 8 * fq;
        float* ssq = (pn == 5 || pn == 6) ? ssq_cq : ((pn == 7 || pn == 8) ? ssq_ckv : nullptr);
#pragma unroll
        for (int ai = 0; ai < 2; ++ai)
#pragma unroll
            for (int m = 0; m < 4; ++m) { const int row = row0 + ai * HALF + m * 16; bf16_t* rowp = O + (size_t)row * INP + col0; float s = 0.f;
#pragma unroll
                for (int bj = 0; bj < 2; ++bj) { const f32x4 v0 = acc[ai][bj][m][0], v1 = acc[ai][bj][m][1];
                    u32x4 w; w.x = cvtpk(v0[0], v0[1]); w.y = cvtpk(v0[2], v0[3]); w.z = cvtpk(v1[0], v1[1]); w.w = cvtpk(v1[2], v1[3]);
                    *(u32x4*)(rowp + bj * HALF) = w;
                    s += (v0[0] * v0[0] + v0[1] * v0[1]) + (v0[2] * v0[2] + v0[3] * v0[3]) + (v1[0] * v1[0] + v1[1] * v1[1]) + (v1[2] * v1[2] + v1[3] * v1[3]); }
                if (ssq) { s += __shfl_xor(s, 16); s += __shfl_xor(s, 32); if (fq == 0) atomicAdd(ssq + row, s); } }
    }
};
struct EpiUpProj {
    static constexpr bool PERM = true; static constexpr int NPRE = 0;
    bf16_t* O; const float* ssq_cq; const float* ssq_ckv; float* kvmp; LAS float* xch; const float* g_kn;
    __device__ __forceinline__ void operator()(const f32x4 (&acc)[2][2][4][2], const Unit& u, int wr, int wc, int fr, int fq) const {
        const int row0 = u.pm * BM + wr * 64 + fr, col0 = u.pn * BM + wc * 32 + 8 * fq;
        if (u.kind == 1) {
#pragma unroll
            for (int ai = 0; ai < 2; ++ai)
#pragma unroll
                for (int m = 0; m < 4; ++m) { float* rowp = kvmp + ((size_t)u.ks * MMEM + row0 + ai * HALF + m * 16) * 1024 + col0;
#pragma unroll
                    for (int bj = 0; bj < 2; ++bj) { *(f32x4*)(rowp + bj * HALF) = acc[ai][bj][m][0]; *(f32x4*)(rowp + bj * HALF + 4) = acc[ai][bj][m][1]; } }
            return;
        }
        const float* ssq = (u.pn < 3) ? ssq_cq : ssq_ckv;
        float rstd[2][4];
#pragma unroll
        for (int ai = 0; ai < 2; ++ai)
#pragma unroll
            for (int m = 0; m < 4; ++m) rstd[ai][m] = __builtin_amdgcn_rsqf(ssq[row0 + ai * HALF + m * 16] * (1.0f / 512) + EPS);
        if (u.pn >= 3) {
#pragma unroll
            for (int ai = 0; ai < 2; ++ai)
#pragma unroll
                for (int m = 0; m < 4; ++m) { const f32x4 a0 = acc[ai][0][m][0] * rstd[ai][m], a1 = acc[ai][0][m][1] * rstd[ai][m];
                    float s = (a0[0] * a0[0] + a0[1] * a0[1]) + (a0[2] * a0[2] + a0[3] * a0[3]) + (a1[0] * a1[0] + a1[1] * a1[1]) + (a1[2] * a1[2] + a1[3] * a1[3]);
                    s += __shfl_xor(s, 16); s += __shfl_xor(s, 32);
                    if (fq == 0) xch[(ai * HALF + wr * 64 + m * 16 + fr) * 4 + wc] = s; }
            asm volatile("s_waitcnt lgkmcnt(0)" ::: "memory"); __builtin_amdgcn_s_barrier(); asm volatile("" ::: "memory");
            float gk[8];
#pragma unroll
            for (int i = 0; i < 8; ++i) gk[i] = g_kn[32 * wc + 8 * fq + i];
#pragma unroll
            for (int ai = 0; ai < 2; ++ai)
#pragma unroll
                for (int m = 0; m < 4; ++m) { const int row = row0 + ai * HALF + m * 16; bf16_t* rowp = O + (size_t)row * NQKV + col0;
                    const f32x4 ps = *(const LAS f32x4*)(xch + (ai * HALF + wr * 64 + m * 16 + fr) * 4);
                    const float r2 = __builtin_amdgcn_rsqf(((ps[0] + ps[1]) + (ps[2] + ps[3])) * (1.0f / 128) + EPS) * rstd[ai][m];
                    { const f32x4 v0 = acc[ai][0][m][0] * r2, v1 = acc[ai][0][m][1] * r2;
                      u32x4 w; w.x = cvtpk(v0[0] * gk[0], v0[1] * gk[1]); w.y = cvtpk(v0[2] * gk[2], v0[3] * gk[3]); w.z = cvtpk(v1[0] * gk[4], v1[1] * gk[5]); w.w = cvtpk(v1[2] * gk[6], v1[3] * gk[7]);
                      *(u32x4*)(rowp) = w; }
                    { const f32x4 v0 = acc[ai][1][m][0] * rstd[ai][m], v1 = acc[ai][1][m][1] * rstd[ai][m];
                      u32x4 w; w.x = cvtpk(v0[0], v0[1]); w.y = cvtpk(v0[2], v0[3]); w.z = cvtpk(v1[0], v1[1]); w.w = cvtpk(v1[2], v1[3]);
                      *(u32x4*)(rowp + HALF) = w; } }
            return;
        }
#pragma unroll
        for (int ai = 0; ai < 2; ++ai)
#pragma unroll
            for (int m = 0; m < 4; ++m) { const int row = row0 + ai * HALF + m * 16; bf16_t* rowp = O + (size_t)row * NQKV + col0;
#pragma unroll
                for (int bj = 0; bj < 2; ++bj) { const f32x4 v0 = acc[ai][bj][m][0] * rstd[ai][m], v1 = acc[ai][bj][m][1] * rstd[ai][m];
                    u32x4 w; w.x = cvtpk(v0[0], v0[1]); w.y = cvtpk(v0[2], v0[3]); w.z = cvtpk(v1[0], v1[1]); w.w = cvtpk(v1[2], v1[3]);
                    *(u32x4*)(rowp + bj * HALF) = w; } }
    }
};
struct EpiOutProj {
    static constexpr bool PERM = true; static constexpr int NPRE = 0;
    const bf16_t* xn; const float* xrms; const float* ginv; bf16_t* hb; float* ssq;
    __device__ __forceinline__ void operator()(const f32x4 (&acc)[2][2][4][2], const Unit& u, int wr, int wc, int fr, int fq) const {
        const int row0 = u.pm * BM + wr * 64 + fr, col0 = u.pn * BM + wc * 32 + 8 * fq;
        f32x4 gi[2][2];
#pragma unroll
        for (int bj = 0; bj < 2; ++bj) { gi[bj][0] = *(const f32x4*)(ginv + col0 + bj * HALF); gi[bj][1] = *(const f32x4*)(ginv + col0 + bj * HALF + 4); }
#pragma unroll
        for (int ai = 0; ai < 2; ++ai) {
            u32x4 xv[4][2]; float rm[4];
#pragma unroll
            for (int m = 0; m < 4; ++m) { const int row = row0 + ai * HALF + m * 16; const size_t off = (size_t)row * DM + col0; rm[m] = xrms[row];
#pragma unroll
                for (int bj = 0; bj < 2; ++bj) xv[m][bj] = *(const u32x4*)(xn + off + bj * HALF); }
            asm volatile("" ::: "memory");
#pragma unroll
            for (int m = 0; m < 4; ++m) { const int row = row0 + ai * HALF + m * 16; const size_t off = (size_t)row * DM + col0; float s = 0.f;
#pragma unroll
                for (int bj = 0; bj < 2; ++bj) { const u32x4 xw = xv[m][bj]; const float r = rm[m];
                    f32x4 x0, x1; x0[0] = bflo(xw.x); x0[1] = bfhi(xw.x); x0[2] = bflo(xw.y); x0[3] = bfhi(xw.y); x1[0] = bflo(xw.z); x1[1] = bfhi(xw.z); x1[2] = bflo(xw.w); x1[3] = bfhi(xw.w);
                    const f32x4 h0 = x0 * (gi[bj][0] * r) + acc[ai][bj][m][0], h1 = x1 * (gi[bj][1] * r) + acc[ai][bj][m][1];
                    u32x4 w; w.x = cvtpk(h0[0], h0[1]); w.y = cvtpk(h0[2], h0[3]); w.z = cvtpk(h1[0], h1[1]); w.w = cvtpk(h1[2], h1[3]);
                    *(u32x4*)(hb + off + bj * HALF) = w;
                    s += (h0[0] * h0[0] + h0[1] * h0[1]) + (h0[2] * h0[2] + h0[3] * h0[3]) + (h1[0] * h1[0] + h1[1] * h1[1]) + (h1[2] * h1[2] + h1[3] * h1[3]); }
                s += __shfl_xor(s, 16); s += __shfl_xor(s, 32);
                if (fq == 0) atomicAdd(ssq + row, s); }
            asm volatile("" ::: "memory");
        }
    }
};
struct EpiSwiGLU {
    static constexpr bool PERM = true; static constexpr int NPRE = 8;
    bf16_t* act; const float* ssq;
    __device__ __forceinline__ void pre(float (&p)[8], const Unit& u, int wr, int wc, int fr, int fq) const {
        const int row0 = u.pm * BM + wr * 64 + fr;
#pragma unroll
        for (int ai = 0; ai < 2; ++ai)
#pragma unroll
            for (int m = 0; m < 4; ++m) p[ai * 4 + m] = ssq[row0 + ai * HALF + m * 16];
    }
    __device__ __forceinline__ void operator()(const f32x4 (&acc)[2][2][4][2], const Unit& u, int wr, int wc, int fr, int fq, const float (&p)[8]) const {
        const int row0 = u.pm * BM + wr * 64 + fr, col0 = u.pn * HALF + wc * 32 + 8 * fq;
        float sq[2][4];
#pragma unroll
        for (int ai = 0; ai < 2; ++ai)
#pragma unroll
            for (int m = 0; m < 4; ++m) sq[ai][m] = p[ai * 4 + m];
#pragma unroll
        for (int ai = 0; ai < 2; ++ai)
#pragma unroll
            for (int m = 0; m < 4; ++m) { const int row = row0 + ai * HALF + m * 16;
                const float rstd = __builtin_amdgcn_rsqf(sq[ai][m] * (1.0f / DM) + EPS);
                float a[8];
#pragma unroll
                for (int n = 0; n < 2; ++n)
#pragma unroll
                    for (int e = 0; e < 4; ++e) { const float g = acc[ai][0][m][n][e] * rstd, up = acc[ai][1][m][n][e] * rstd;
                        const float sg = g * __builtin_amdgcn_rcpf(1.0f + __builtin_amdgcn_exp2f(-g * LOG2E));
                        a[n * 4 + e] = sg * up; }
                *(u32x4*)(act + (size_t)row * DFF + col0) = pack8(a); }
    }
};
struct EpiDown {
    static constexpr bool PERM = true; static constexpr int NPRE = 0;
    float* out; const bf16_t* hb;
    __device__ __forceinline__ void operator()(const f32x4 (&acc)[2][2][4][2], const Unit& u, int wr, int wc, int fr, int fq) const {
        const int row0 = u.pm * BM + wr * 64 + fr, col0 = u.pn * BM + wc * 32 + 8 * fq;
        u32x4 hw[2][4][2];
#pragma unroll
        for (int ai = 0; ai < 2; ++ai)
#pragma unroll
            for (int m = 0; m < 4; ++m) { const size_t off = (size_t)(row0 + ai * HALF + m * 16) * DM + col0;
#pragma unroll
                for (int bj = 0; bj < 2; ++bj) hw[ai][m][bj] = *(const u32x4*)(hb + off + bj * HALF); }
        asm volatile("" ::: "memory");
#pragma unroll
        for (int ai = 0; ai < 2; ++ai)
#pragma unroll
            for (int m = 0; m < 4; ++m) { const size_t off = (size_t)(row0 + ai * HALF + m * 16) * DM + col0;
#pragma unroll
                for (int bj = 0; bj < 2; ++bj) { const u32x4 w = hw[ai][m][bj];
                    f32x4 h0, h1; h0[0] = bflo(w.x); h0[1] = bfhi(w.x); h0[2] = bflo(w.y); h0[3] = bfhi(w.y); h1[0] = bflo(w.z); h1[1] = bfhi(w.z); h1[2] = bflo(w.w); h1[3] = bfhi(w.w);
                    *(f32x4*)(out + off + bj * HALF) = h0 + acc[ai][bj][m][0]; *(f32x4*)(out + off + bj * HALF + 4) = h1 + acc[ai][bj][m][1]; } }
    }
};

template <class Epi, class Sched, bool ALIGN_EPI = true>
__device__ __forceinline__ void gemm_phase(LAS unsigned char* lds, const Gemm g, const Sched& S, const Epi& E) {
    const int tid = threadIdx.x, wid = __builtin_amdgcn_readfirstlane(tid >> 6), lane = tid & 63, wr = wid >> 2, wc = wid & 3, fr = lane & 15, fq = lane >> 4;
    const int K = g.K, nt = K / BK;
    unsigned voffA[2], voffB[2];
#pragma unroll
    for (int i = 0; i < 2; ++i) { int R, C; stage_rc(tid * 16 + i * 8192, R, C); const int Rb = Epi::PERM ? ((R & ~31) + perm32(R & 31)) : R;
        voffA[i] = (unsigned)(R * g.lda + C) * 2u; voffB[i] = (unsigned)(Rb * g.ldb + C) * 2u; }
    const size_t kstep = (size_t)(BK * 2);
    const size_t hstepA = (size_t)HALF * g.lda * 2, hstepB = (size_t)HALF * g.ldb * 2;
    const unsigned ldsw = (unsigned)wid * 1024u;
    const int aoff = lds_byte(wr * 64 + fr, fq * 8), boff = lds_byte(wc * 32 + fr, fq * 8);
#define PG8_SA(b, h) (((b) * 2 + (h)) * HTB)
#define PG8_SB(b, h) ((4 + (b) * 2 + (h)) * HTB)
#define PG8_STAGE(bufoff, gbase, voff) do { _Pragma("unroll") for (int _i = 0; _i < 2; ++_i) \
        __builtin_amdgcn_global_load_lds((const unsigned*)((const char*)(gbase) + (voff)[_i]), (LAS unsigned*)(lds + (bufoff) + ldsw + _i * 8192), 16, 0, 0); } while (0)
#define PG8_LDA(dst, b, h) do { _Pragma("unroll") for (int m = 0; m < 4; ++m) _Pragma("unroll") for (int k = 0; k < 2; ++k) dst[m][k] = *(const LAS bf16x8*)(lds + PG8_SA(b, h) + aoff + m * 2048 + k * 1024); } while (0)
#define PG8_LDB(dst, b, h) do { _Pragma("unroll") for (int n = 0; n < 2; ++n) _Pragma("unroll") for (int k = 0; k < 2; ++k) dst[n][k] = *(const LAS bf16x8*)(lds + PG8_SB(b, h) + boff + n * 2048 + k * 1024); } while (0)
#define PG8_MMA(ai, bj, At, Bt) do { __builtin_amdgcn_s_setprio(1); _Pragma("unroll") for (int m = 0; m < 4; ++m) _Pragma("unroll") for (int n = 0; n < 2; ++n) _Pragma("unroll") for (int k = 0; k < 2; ++k) \
        acc[ai][bj][m][n] = __builtin_amdgcn_mfma_f32_16x16x32_bf16(Bt[n][k], At[m][k], acc[ai][bj][m][n], 0, 0, 0); __builtin_amdgcn_s_setprio(0); } while (0)
#define PG8_WAIT_V(n) asm volatile("s_waitcnt vmcnt(" #n ")" ::: "memory")
#define PG8_WAIT_L(n) asm volatile("s_waitcnt lgkmcnt(" #n ")" ::: "memory")
#define PG8_BAR __builtin_amdgcn_s_barrier()
#define PG8_SCHED __builtin_amdgcn_sched_barrier(0)
    Unit cur, nxt; int ui = 0;
    if (!S.next(0, cur)) return;
    f32x4 acc[2][2][4][2];
#pragma unroll
    for (int a = 0; a < 2; ++a)
#pragma unroll
        for (int b = 0; b < 2; ++b)
#pragma unroll
            for (int m = 0; m < 4; ++m)
#pragma unroll
                for (int n = 0; n < 2; ++n) acc[a][b][m][n] = (f32x4){0.f, 0.f, 0.f, 0.f};
    bf16x8 At[4][2], B0[2][2], B1[2][2];
    float epf[Epi::NPRE > 0 ? Epi::NPRE : 1];
    const char* cA; const char* cB; S.ptrs(g, cur, cA, cB);
    PG8_STAGE(PG8_SB(0, 0), cB, voffB); PG8_STAGE(PG8_SB(0, 1), cB + hstepB, voffB); PG8_STAGE(PG8_SA(0, 0), cA, voffA); PG8_STAGE(PG8_SA(0, 1), cA + hstepA, voffA);
    if (wr == 1) PG8_BAR;
    PG8_WAIT_V(2); PG8_BAR;
    PG8_STAGE(PG8_SB(1, 0), cB + kstep, voffB); PG8_STAGE(PG8_SA(1, 0), cA + kstep, voffA); PG8_STAGE(PG8_SB(1, 1), cB + hstepB + kstep, voffB);
    PG8_WAIT_V(6); PG8_BAR;
    for (;;) {
        const bool has_next = S.next(ui + 1, nxt);
        const char* nA = cA; const char* nB = cB; if (has_next) S.ptrs(g, nxt, nA, nB);
        for (int t = 0; t < nt; t += 2) {
            const bool last = (t == nt - 2);
            if constexpr (Epi::NPRE > 0) { if (last) E.pre(epf, cur, wr, wc, fr, fq); }
            const char* a1 = cA + (size_t)(t + 1) * kstep;
            const char* a2 = last ? nA : cA + (size_t)(t + 2) * kstep; const char* b2 = last ? nB : cB + (size_t)(t + 2) * kstep;
            const char* a3 = a2 + kstep; const char* b3 = b2 + kstep;
            PG8_LDB(B0, 0, 0); PG8_LDB(B1, 0, 1); PG8_SCHED; PG8_LDA(At, 0, 0); PG8_STAGE(PG8_SA(1, 1), a1 + hstepA, voffA);
            PG8_WAIT_V(8); PG8_WAIT_L(0); PG8_BAR; PG8_MMA(0, 0, At, B0); PG8_MMA(0, 1, At, B1); PG8_BAR; PG8_SCHED;
            PG8_LDA(At, 0, 1); PG8_STAGE(PG8_SB(0, 0), b2, voffB); PG8_STAGE(PG8_SB(0, 1), b2 + hstepB, voffB); PG8_STAGE(PG8_SA(0, 0), a2, voffA);
            PG8_WAIT_V(8); PG8_WAIT_L(0); PG8_BAR; PG8_MMA(1, 0, At, B0); PG8_MMA(1, 1, At, B1); PG8_BAR; PG8_SCHED;
            PG8_LDB(B0, 1, 0); PG8_LDB(B1, 1, 1); PG8_SCHED; PG8_LDA(At, 1, 0); PG8_STAGE(PG8_SA(0, 1), a2 + hstepA, voffA);
            PG8_WAIT_V(8); PG8_WAIT_L(0); PG8_BAR; PG8_MMA(0, 0, At, B0); PG8_MMA(0, 1, At, B1); PG8_BAR; PG8_SCHED;
            PG8_LDA(At, 1, 1); PG8_STAGE(PG8_SB(1, 0), b3, voffB); PG8_STAGE(PG8_SB(1, 1), b3 + hstepB, voffB); PG8_STAGE(PG8_SA(1, 0), a3, voffA);
            PG8_WAIT_V(8); PG8_WAIT_L(0); PG8_BAR; PG8_MMA(1, 0, At, B0); PG8_MMA(1, 1, At, B1); PG8_BAR; PG8_SCHED;
        }
        if constexpr (ALIGN_EPI) { if (wr == 0) PG8_BAR; }
        if constexpr (Epi::NPRE > 0) E(acc, cur, wr, wc, fr, fq, epf); else E(acc, cur, wr, wc, fr, fq);
        if (!has_next) break;
#pragma unroll
        for (int a = 0; a < 2; ++a)
#pragma unroll
            for (int b = 0; b < 2; ++b)
#pragma unroll
                for (int m = 0; m < 4; ++m)
#pragma unroll
                    for (int n = 0; n < 2; ++n) acc[a][b][m][n] = (f32x4){0.f, 0.f, 0.f, 0.f};
        cur = nxt; cA = nA; cB = nB; ++ui;
        if constexpr (ALIGN_EPI) { if (wr == 1) PG8_BAR; }
    }
    PG8_WAIT_V(0);
    if constexpr (!ALIGN_EPI) { if (wr == 0) PG8_BAR; }
    PG8_BAR;
#undef PG8_SA
#undef PG8_SB
#undef PG8_STAGE
#undef PG8_LDA
#undef PG8_LDB
#undef PG8_MMA
#undef PG8_WAIT_V
#undef PG8_WAIT_L
#undef PG8_BAR
#undef PG8_SCHED
}
}


#define XB_TMO      128
#define XB_XCNT(j)  (256  + 64 * (j))
#define XB_XSUB(j)  (1280 + 64 * (j))
#define XB_XGEN(j)  (2304 + 64 * (j))
#define XB_TOP      3328
#define XB_TOPGEN   3392
#define XCD_BAR_WORDS 3456
#define XB_SPIN_CAP (1u << 18)
__device__ __forceinline__ unsigned xb_ld(unsigned* p)              { return __hip_atomic_load(p, __ATOMIC_RELAXED, __HIP_MEMORY_SCOPE_AGENT); }
__device__ __forceinline__ unsigned xb_add(unsigned* p, unsigned v) { return __hip_atomic_fetch_add(p, v, __ATOMIC_RELAXED, __HIP_MEMORY_SCOPE_AGENT); }
__device__ __forceinline__ unsigned xb_xcc_id() { return (unsigned)__builtin_amdgcn_s_getreg((3 << 11) | 20) & 0xFu; }
#define XB_SPIN(cond, bar) do { unsigned _sp = 0; while (cond) { __builtin_amdgcn_s_sleep(1); \
    if ((++_sp & 255u) == 0u) { if (xb_ld(&(bar)[XB_TMO])) break; if (_sp > XB_SPIN_CAP) { atomicAdd(&(bar)[XB_TMO], 1u); break; } } } } while (0)
struct XcdBarrier { unsigned* bar; unsigned x; volatile LAS unsigned* st; };
__device__ __forceinline__ XcdBarrier xcd_barrier_post(unsigned* bar, volatile LAS unsigned* st) {
    XcdBarrier b; b.bar = bar; b.x = xb_xcc_id(); b.st = st;
    if (threadIdx.x == 0) (void)xb_add(&bar[XB_XCNT(b.x)], 1u);
    return b;
}
__device__ __forceinline__ void xcd_barrier_complete(unsigned* bar, unsigned x, unsigned& nloc, unsigned& nx) {
    const unsigned G = gridDim.x * gridDim.y * gridDim.z;
    unsigned sum, cnt, mine, sp = 0u;
    for (;;) {
        sum = 0u; cnt = 0u; mine = 0u;
#pragma unroll
        for (unsigned j = 0; j < 16; ++j) { const unsigned c = xb_ld(&bar[XB_XCNT(j)]); sum += c; cnt += (c > 0u) ? 1u : 0u; mine = (j == x) ? c : mine; }
        if (sum == G) break;
        __builtin_amdgcn_s_sleep(1);
        if ((++sp & 255u) == 0u) { if (xb_ld(&bar[XB_TMO])) break; if (sp > XB_SPIN_CAP) { atomicAdd(&bar[XB_TMO], 1u); break; } }
    }
    nloc = mine > 0u ? mine : 1u; nx = cnt > 0u ? cnt : 1u;
}
__device__ __forceinline__ void xcd_barrier(const XcdBarrier& b) {
    asm volatile("s_waitcnt vmcnt(0)" ::: "memory");
    __syncthreads();
    if (threadIdx.x == 0) {
        unsigned* bar = b.bar;
        __builtin_amdgcn_s_waitcnt(0);
        unsigned nloc = b.st[0], nx = b.st[1];
        if (nloc == 0u) { xcd_barrier_complete(bar, b.x, nloc, nx); b.st[0] = nloc; b.st[1] = nx; }
        const unsigned old = xb_add(&bar[XB_XSUB(b.x)], 1u);
        const unsigned gen = old / nloc;
        if (old + 1u == (gen + 1u) * nloc) {
            __builtin_amdgcn_fence(__ATOMIC_RELEASE, "agent");
            asm volatile("s_waitcnt vmcnt(0)" ::: "memory");
            const unsigned og = xb_add(&bar[XB_TOP], 1u);
            const unsigned tg = og / nx;
            if (og + 1u == (tg + 1u) * nx) xb_add(&bar[XB_TOPGEN], 1u);
            else XB_SPIN(xb_ld(&bar[XB_TOPGEN]) == tg, bar);
            __builtin_amdgcn_fence(__ATOMIC_ACQUIRE, "agent");
            xb_add(&bar[XB_XGEN(b.x)], 1u);
            asm volatile("s_waitcnt vmcnt(0)" ::: "memory");
        } else {
            XB_SPIN(xb_ld(&bar[XB_XGEN(b.x)]) == gen, bar);
            __builtin_amdgcn_fence(__ATOMIC_ACQUIRE, "agent");
            asm volatile("s_waitcnt vmcnt(0)" ::: "memory");
        }
    }
    __syncthreads();
}

struct Args { const void* in[25]; float* out; unsigned char* ws; int lo, hi, att_lo, att_hi; };

__device__ __forceinline__ void p0_transpose_item(const float* W, int K, int N, bf16_t* WT, int mode, const float* kscale, LAS unsigned* scr, int item, int lane, int kslice = 0) {
    const int nblk = N / 64, kb = item / nblk, nb = item % nblk, k0 = 64 * kb, n0 = 64 * nb;
    const int lr = lane >> 4, lc = (lane & 15) * 4;
    f32x4 va[8], vb[8];
#pragma unroll
    for (int i = 0; i < 8; ++i) { const int kp = lr + 4 * i; const float* p = W + (size_t)(k0 + 2 * kp) * N + n0 + lc; va[i] = *(const f32x4*)p; vb[i] = *(const f32x4*)(p + N); }
#pragma unroll
    for (int i = 0; i < 8; ++i) { const int kp = lr + 4 * i;
        if (kscale) { const float s0 = kscale[k0 + 2 * kp], s1 = kscale[k0 + 2 * kp + 1]; va[i] = va[i] * s0; vb[i] = vb[i] * s1; }
        LAS unsigned* d = scr + kp * 65 + lc;
        d[0] = cvtpk(va[i].x, vb[i].x); d[1] = cvtpk(va[i].y, vb[i].y); d[2] = cvtpk(va[i].z, vb[i].z); d[3] = cvtpk(va[i].w, vb[i].w); }
    asm volatile("s_waitcnt lgkmcnt(0)" ::: "memory");
    const int c = lane & 7;
    const bool special = (mode == 3) && ((n0 >> 8) == 4 || (n0 >> 8) == 9);
    const int r0 = (mode == 0 || mode == 3) ? n0 : ((n0 >> 7) * 256 + (n0 & 127) + (mode == 2 ? 128 : 0));
#pragma unroll
    for (int j = 0; j < 8; ++j) { const int n = (lane >> 3) + 8 * j; const LAS unsigned* sp = scr + (4 * c) * 65 + n;
        u32x4 o; o.x = sp[0]; o.y = sp[65]; o.z = sp[130]; o.w = sp[195];
        const int row = special ? ((n0 & ~255) + 128 * (n >> 5) + 32 * ((n0 >> 6) & 3) + (n & 31)) : (r0 + n);
        if (kslice) *(u32x4*)(WT + (size_t)(k0 / kslice) * N * kslice + (size_t)row * kslice + (k0 % kslice) + 8 * c) = o;
        else *(u32x4*)(WT + (size_t)row * K + k0 + 8 * c) = o; }
    asm volatile("s_waitcnt lgkmcnt(0)" ::: "memory");
}
__device__ __forceinline__ void rms_row2_to_bf16(const float* xrow0, const float* xrow1, const float* g, bf16_t* orow0, bf16_t* orow1, int lane, float* rms0 = nullptr) {
    const f32x4* xa = (const f32x4*)xrow0 + lane; const f32x4* xb = (const f32x4*)xrow1 + lane; const f32x4* gr = (const f32x4*)g + lane;
    f32x4 va[8], vb[8]; float sa = 0.f, sb = 0.f;
#pragma unroll
    for (int j = 0; j < 8; ++j) { va[j] = xa[64 * j]; vb[j] = xb[64 * j]; }
#pragma unroll
    for (int j = 0; j < 8; ++j) { sa += (va[j].x * va[j].x + va[j].y * va[j].y) + (va[j].z * va[j].z + va[j].w * va[j].w); sb += (vb[j].x * vb[j].x + vb[j].y * vb[j].y) + (vb[j].z * vb[j].z + vb[j].w * vb[j].w); }
    const float qa = sqrtf(group_sum<64>(sa) * (1.0f / DM) + EPS), qb = sqrtf(group_sum<64>(sb) * (1.0f / DM) + EPS);
    const float ra = 1.0f / qa, rb = 1.0f / qb;
    if (rms0 && lane == 0) { rms0[0] = qa; rms0[1] = qb; }
    u32x2* oa = (u32x2*)orow0 + lane; u32x2* ob = (u32x2*)orow1 + lane;
#pragma unroll
    for (int j = 0; j < 8; ++j) { const f32x4 gg = gr[64 * j];
        u32x2 w; w.x = cvtpk(va[j].x * ra * gg.x, va[j].y * ra * gg.y); w.y = cvtpk(va[j].z * ra * gg.z, va[j].w * ra * gg.w); oa[64 * j] = w;
        u32x2 w2; w2.x = cvtpk(vb[j].x * rb * gg.x, vb[j].y * rb * gg.y); w2.y = cvtpk(vb[j].z * rb * gg.z, vb[j].w * rb * gg.w); ob[64 * j] = w2; }
}

constexpr int N_MLA_UNITS = 256, N_MEM_UNITS = 64, N_SWA_UNITS = 256, N_ATT_UNITS = N_MLA_UNITS + N_MEM_UNITS + N_SWA_UNITS;
constexpr int CV_OUT = (DM / 64) * (DM / 64), CV_G = (DM / 64) * (DFF / 64), CV_DN = (DFF / 64) * (DM / 64), CV_ITEMS = CV_OUT + 2 * CV_G + CV_DN, N_CONV_UNITS = CV_ITEMS / 8;
static_assert(CV_ITEMS % 8 == 0, "conversion items per unit");
constexpr int N_QUEUE_UNITS = N_ATT_UNITS + N_CONV_UNITS;
__device__ __forceinline__ int crow(int r, int hi) { return (r & 3) + 8 * (r >> 2) + 4 * hi; }


template <int S0, int NSEG> __device__ __forceinline__ float qseg_rstd(const bf16x8* qf, float qscale) {
    float ss = 0.f;
#pragma unroll
    for (int s = 0; s < NSEG; ++s) { float f[8]; unpack8(__builtin_bit_cast(u32x4, qf[S0 + s]), f);
#pragma unroll
        for (int j = 0; j < 8; ++j) ss += f[j] * f[j]; }
    ss += __shfl_xor(ss, 32);
    return 1.0f / sqrtf(ss * (1.0f / (16 * NSEG)) + EPS) * qscale;
}
__device__ __forceinline__ void qfrag_scale(const bf16x8 q, const float* g, float rstd, float (&f)[8]) {
    unpack8(__builtin_bit_cast(u32x4, q), f);
    const f32x4 g0 = *(const f32x4*)g, g1 = *(const f32x4*)(g + 4);
    f[0] *= rstd * g0[0]; f[1] *= rstd * g0[1]; f[2] *= rstd * g0[2]; f[3] *= rstd * g0[3];
    f[4] *= rstd * g1[0]; f[5] *= rstd * g1[1]; f[6] *= rstd * g1[2]; f[7] *= rstd * g1[3];
}
template <int S0, int NSEG> __device__ __forceinline__ void qseg_norm(bf16x8* qf, const float* g, float qscale, int hi) {
    const float rstd = qseg_rstd<S0, NSEG>(qf, qscale);
#pragma unroll
    for (int s = 0; s < NSEG; ++s) { float f[8]; qfrag_scale(qf[S0 + s], g + 16 * s + 8 * hi, rstd, f); qf[S0 + s] = __builtin_bit_cast(bf16x8, pack8(f)); }
}
__device__ __forceinline__ void at_glds16(const void* gsrc, unsigned lds_dst) { unsigned keep;
    asm volatile("s_mov_b32 %0, m0\n\ts_mov_b32 m0, %2\n\ts_nop 0\n\tglobal_load_lds_dwordx4 %1, off\n\ts_mov_b32 m0, %0" : "=&s"(keep) : "v"(gsrc), "s"(lds_dst) : "memory"); }
template <int N> __device__ __forceinline__ void at_wait_vm() { asm volatile("s_waitcnt vmcnt(%0)" :: "n"(N) : "memory"); }
template <int D0, int D1> __device__ __forceinline__ const char* at_ksrc3(const bf16_t* k0, int ld0, const bf16_t* k1, int ld1, int key0, int col0, unsigned ko0, unsigned ko1) {
    if constexpr (D1 == 0) { return (const char*)k0 + ((size_t)key0 * ld0 + col0) * 2 + ko0; }
    else { return (col0 < D0) ? ((const char*)k0 + ((size_t)key0 * ld0 + col0) * 2 + ko0) : ((const char*)k1 + ((size_t)key0 * ld1 + (col0 - D0)) * 2 + ko1); }
}
template <int D0, int D1> __device__ __forceinline__ const char* at_ksrc2(const bf16_t* k0, int ld0, const bf16_t* k1, int ld1, int t, int c, unsigned ko0, unsigned ko1) {
    if constexpr (D1 == 0) { return (const char*)k0 + ((size_t)t * 64 * ld0 + c * 8) * 2 + ko0; }
    else { return (c * 8 < D0) ? ((const char*)k0 + ((size_t)t * 64 * ld0 + c * 8) * 2 + ko0) : ((const char*)k1 + ((size_t)t * 64 * ld1 + (c * 8 - D0)) * 2 + ko1); }
}
template <int D0, int D1> __device__ __forceinline__ const bf16_t* at_ksrc(const bf16_t* k0, int ld0, const bf16_t* k1, int ld1, size_t key, int c) {
    if constexpr (D1 == 0) { return k0 + key * ld0 + c * 8; }
    else { return (c * 8 < D0) ? (k0 + key * ld0 + c * 8) : (k1 + key * ld1 + (c * 8 - D0)); }
}
template <int D0, int D1, int DV, int MODE>
__device__ __forceinline__ void attn_unit(LAS unsigned char* lds, const bf16_t* qw, int q_ld, const bf16_t* k0, int ld0, const bf16_t* k1, int ld1, const bf16_t* vp, int ldv,
                                          bf16_t* ow, int o_ld, int t_begin, int t_end,
                                          int qabs  , int wave_tmax  , int wave_tmin,
                                          float slope2, float sink2, int pos_q, const int* posk_g  , bool first_block, const float* qg0, const float* qg1) {
    constexpr int DQK = D0 + D1, NKC = DQK / 8, KBYTES = DQK * 128, VBYTES = DV * 128, TBYTES = KBYTES + VBYTES, KI = NKC / 8, VI = DV / 64  , NS = DQK / 16, NDB = DV / 32;
    constexpr int NDMA = KI + VI;
    static_assert(3 * TBYTES + 1024 <= RING_BYTES, "attention LDS");
    int tid_ = threadIdx.x; asm volatile("" : "+v"(tid_));
    asm volatile("" : "+s"(qg0), "+s"(qg1));
    asm volatile("" : "+s"(t_begin), "+s"(t_end));
    const int tid = tid_, lane = tid & 63, wid = __builtin_amdgcn_readfirstlane(tid >> 6), r32 = lane & 31, hi = lane >> 5;
    LAS float* poskf = (LAS float*)(lds + 3 * TBYTES); const float pos_qf = (float)pos_q;
    const int voff = ((4 * hi + ((lane & 15) >> 2)) * 64) + (((lane >> 4) & 1) * 32) + ((lane & 3) * 8);
    const unsigned lds0 = (unsigned)(size_t)lds;
    const unsigned kr_ = (unsigned)(lane >> 3), kc_ = ((unsigned)(lane & 7) ^ kr_ ^ (unsigned)((wid >> 1) & 1));
    const unsigned ko0 = kr_ * (unsigned)ld0 * 2u + kc_ * 16u, ko1 = kr_ * (unsigned)ld1 * 2u + kc_ * 16u, vo = ((unsigned)(lane >> 2) * (unsigned)ldv + (unsigned)(lane & 3) * 8u) * 2u;
    unsigned kro[4];
#pragma unroll
    for (int j = 0; j < 4; ++j) kro[j] = (unsigned)((r32 >> 3) * 1024 + (r32 & 7) * 128) + (((unsigned)(2 * j + hi) ^ (unsigned)(r32 & 7) ^ (unsigned)((r32 >> 4) & 1)) * 16u);
#define AT_DMA(t, b) do { \
        _Pragma("unroll") for (int i = 0; i < KI; ++i) {   \
            const char* src = at_ksrc3<D0, D1>(k0, ld0, k1, ld1, (t) * 64 + 8 * wid, i * 64, ko0, ko1); \
            at_glds16(src, (unsigned)__builtin_amdgcn_readfirstlane((int)(lds0 + (unsigned)((b) * TBYTES + (i * 8 + wid) * 1024)))); } \
        _Pragma("unroll") for (int i = 0; i < VI; ++i) { const int p = wid + 8 * i, dblk = p >> 2, ks = p & 3; \
            const char* src = (const char*)vp + (((size_t)(t) * 64 + ks * 16) * ldv + dblk * 32) * 2 + vo; \
            at_glds16(src, (unsigned)__builtin_amdgcn_readfirstlane((int)(lds0 + (unsigned)((b) * TBYTES + KBYTES + p * 1024)))); } } while (0)
#define AT_BAR() do { asm volatile("" ::: "memory"); __builtin_amdgcn_s_barrier(); asm volatile("" ::: "memory"); } while (0)
    const int nt = t_end - t_begin;
    AT_DMA(t_begin, 0);
    if (nt > 1) AT_DMA(t_begin + 1, 1);
    if constexpr (MODE == 2) { if (tid < 256) poskf[tid] = (first_block && tid < 128) ? 0.f : (float)posk_g[tid]; }
    bf16x8 qf[NS];
#pragma unroll
    for (int s = 0; s < NS; ++s) qf[s] = *(const bf16x8*)(qw + (size_t)r32 * q_ld + 16 * s + 8 * hi);
    if constexpr (MODE == 0) qseg_norm<0, 8>(qf, qg0, QS_MEM, hi);
    if constexpr (MODE == 2) qseg_norm<0, 4>(qf, qg0, QS_SWA, hi);
    if constexpr (MODE == 1) {
        qseg_norm<0, 8>(qf, qg0, QS_MLA, hi);
        const float rstd = qseg_rstd<8, 4>(qf, QS_MLA);
#pragma unroll
        for (int sp = 0; sp < 2; ++sp) { float fa[8], fb[8]; qfrag_scale(qf[8 + sp], qg1 + 16 * sp + 8 * hi, rstd, fa); qfrag_scale(qf[10 + sp], qg1 + 16 * (sp + 2) + 8 * hi, rstd, fb);
#pragma unroll
            for (int j = 0; j < 8; ++j) { float c_, s_; rope_cs(pos_q, 16 * sp + 8 * hi + j, c_, s_); const float x1 = fa[j], x2 = fb[j]; fa[j] = x1 * c_ - x2 * s_; fb[j] = x1 * s_ + x2 * c_; }
            qf[8 + sp] = __builtin_bit_cast(bf16x8, pack8(fa)); qf[10 + sp] = __builtin_bit_cast(bf16x8, pack8(fb)); }
    }
    f32x16 o[NDB];
#pragma unroll
    for (int d = 0; d < NDB; ++d)
#pragma unroll
        for (int r = 0; r < 16; ++r) o[d][r] = 0.f;
    float m_run = (MODE == 2) ? sink2 : -1e30f, l_run = (MODE == 2 && hi == 0) ? 1.f : 0.f;
    if (nt > 1) at_wait_vm<NDMA>(); else at_wait_vm<0>();
    asm volatile("s_waitcnt lgkmcnt(0)" ::: "memory");
    AT_BAR();
    constexpr int NG = NS / 2;
#define AT_KRD(dst, g) do { _Pragma("unroll") for (int s4 = 0; s4 < 2; ++s4) { const int s_ = (g) * 2 + s4; dst[s4][0] = *(const LAS bf16x8*)(kb + kro[s_ & 3] + (s_ >> 2) * 8192); dst[s4][1] = *(const LAS bf16x8*)(kb + kro[s_ & 3] + (s_ >> 2) * 8192 + 4096); } } while (0)
#define AT_KMM(src, g) do { _Pragma("unroll") for (int s4 = 0; s4 < 2; ++s4) { p0 = __builtin_amdgcn_mfma_f32_32x32x16_bf16(src[s4][0], qf[(g) * 2 + s4], p0, 0, 0, 0); p1 = __builtin_amdgcn_mfma_f32_32x32x16_bf16(src[s4][1], qf[(g) * 2 + s4], p1, 0, 0, 0); } } while (0)
#define AT_VRD(dst, d) do { _Pragma("unroll") for (int ks = 0; ks < 4; ++ks) { \
        dst[ks][0] = __builtin_bit_cast(s16x4, __builtin_amdgcn_ds_read_tr16_b64_v4i16((LAS s16x4*)(vb + ((d) * 4 + ks) * 1024))); \
        dst[ks][1] = __builtin_bit_cast(s16x4, __builtin_amdgcn_ds_read_tr16_b64_v4i16((LAS s16x4*)(vb + ((d) * 4 + ks) * 1024 + 512))); } } while (0)
#define AT_VMM(src, d) do { } while (0)
#define AT_VMM2(src, d) do { _Pragma("unroll") for (int ks = 0; ks < 4; ++ks) { \
        const bf16x8 vf = (bf16x8){src[ks][0][0], src[ks][0][1], src[ks][0][2], src[ks][0][3], src[ks][1][0], src[ks][1][1], src[ks][1][2], src[ks][1][3]}; \
        o[d] = __builtin_amdgcn_mfma_f32_32x32x16_bf16(vf, __builtin_bit_cast(bf16x8, pw[ks]), o[d], 0, 0, 0); } } while (0)
#define AT_STEP(B, B2) do { \
        const int t = t_begin + jt; \
        const bool active = (t >= wave_tmin && t <= wave_tmax), more = (jt + 2 < nt); \
        if (more) AT_DMA(t + 2, (B2)); \
        if (active) { \
            const LAS unsigned char* kb = lds + (B) * TBYTES; \
            const LAS unsigned char* vb = lds + (B) * TBYTES + KBYTES + voff; \
            f32x16 p0, p1; \
        _Pragma("unroll") \
            for (int r = 0; r < 16; ++r) { p0[r] = 0.f; p1[r] = 0.f; } \
            { bf16x8 kf[2][2][2]; \
              AT_KRD(kf[0], 0); \
        _Pragma("unroll") \
              for (int g = 0; g < NG; ++g) { \
                  if (g + 1 < NG) AT_KRD(kf[(g + 1) & 1], g + 1); \
                  __builtin_amdgcn_sched_barrier(0); AT_KMM(kf[g & 1], g); __builtin_amdgcn_sched_barrier(0); } } \
            s16x4 va[4][2]; AT_VRD(va, 0); __builtin_amdgcn_sched_barrier(0); \
            if (MODE == 1) { \
                if (t * 64 + 63 > qabs - r32) { \
        _Pragma("unroll") \
                    for (int r = 0; r < 16; ++r) { const int key = t * 64 + crow(r, hi); if (key > qabs) p0[r] = -1e30f; if (key + 32 > qabs) p1[r] = -1e30f; } \
                } \
            } \
            float mx = p0[0]; \
        _Pragma("unroll") \
            for (int r = 1; r < 16; ++r) mx = fmaxf(mx, p0[r]); \
        _Pragma("unroll") \
            for (int r = 0; r < 16; ++r) mx = fmaxf(mx, p1[r]); \
            mx = fmaxf(mx, __shfl_xor(mx, 32)); \
              \
            const float mn = (mx > m_run + 8.0f) ? mx : m_run, alpha = __builtin_amdgcn_exp2f(m_run - mn); m_run = mn; \
            float rs = 0.f; \
        _Pragma("unroll") \
            for (int r = 0; r < 16; ++r) { p0[r] = __builtin_amdgcn_exp2f(p0[r] - mn); p1[r] = __builtin_amdgcn_exp2f(p1[r] - mn); rs += p0[r] + p1[r]; } \
            l_run = l_run * alpha + rs; \
            if (__builtin_amdgcn_ballot_w64(alpha != 1.0f) != 0ull) { \
        _Pragma("unroll") \
                for (int d = 0; d < NDB; ++d) \
        _Pragma("unroll") \
                    for (int r = 0; r < 16; ++r) o[d][r] *= alpha; \
            } \
            u32x4 pw[4]; \
        _Pragma("unroll") \
            for (int e = 0; e < 4; ++e) { pw[0][e] = cvtpk(p0[2 * e], p0[2 * e + 1]); pw[1][e] = cvtpk(p0[8 + 2 * e], p0[8 + 2 * e + 1]); pw[2][e] = cvtpk(p1[2 * e], p1[2 * e + 1]); pw[3][e] = cvtpk(p1[8 + 2 * e], p1[8 + 2 * e + 1]); } \
            { if constexpr (NDB > 1) { s16x4 vc[4][2]; AT_VRD(vc, 1); __builtin_amdgcn_sched_barrier(0); AT_VMM2(va, 0); __builtin_amdgcn_sched_barrier(0); \
                if constexpr (NDB > 2) { AT_VRD(va, 2); __builtin_amdgcn_sched_barrier(0); AT_VMM2(vc, 1); __builtin_amdgcn_sched_barrier(0); \
                  AT_VRD(vc, 3); __builtin_amdgcn_sched_barrier(0); AT_VMM2(va, 2); __builtin_amdgcn_sched_barrier(0); AT_VMM2(vc, 3); } \
                else { AT_VMM2(vc, 1); } } \
              else { AT_VMM2(va, 0); } } \
        } \
        if (more) at_wait_vm<NDMA>(); else at_wait_vm<0>(); \
        AT_BAR(); \
    } while (0)
    if (wid >= 4) __builtin_amdgcn_s_setprio(1);
    for (int jt = 0; jt < nt; ) {
        AT_STEP(0, 2); if (++jt >= nt) break;
        AT_STEP(1, 0); if (++jt >= nt) break;
        AT_STEP(2, 1); ++jt;
    }
#undef AT_STEP
    __builtin_amdgcn_s_setprio(0);
#undef AT_KRD
#undef AT_KMM
#undef AT_VRD
#undef AT_VMM
#undef AT_VMM2
#undef AT_DMA
#undef AT_BAR
    const float lt = l_run + __shfl_xor(l_run, 32);
    const float inv = __builtin_amdgcn_rcpf(lt);
    bf16_t* orow = ow + (size_t)r32 * o_ld;
#pragma unroll
    for (int d = 0; d < NDB; ++d)
#pragma unroll
        for (int j2 = 0; j2 < 2; ++j2) {
            u32x2 P0, P1;
            P0.x = cvtpk(o[d][8 * j2] * inv, o[d][8 * j2 + 1] * inv); P0.y = cvtpk(o[d][8 * j2 + 2] * inv, o[d][8 * j2 + 3] * inv);
            P1.x = cvtpk(o[d][8 * j2 + 4] * inv, o[d][8 * j2 + 5] * inv); P1.y = cvtpk(o[d][8 * j2 + 6] * inv, o[d][8 * j2 + 7] * inv);
            const unsigned sx = hi ? P0.x : P1.x, sy = hi ? P0.y : P1.y;
            const unsigned rx = (unsigned)__shfl_xor((int)sx, 32), ry = (unsigned)__shfl_xor((int)sy, 32);
            u32x4 w;
            if (hi == 0) { w.x = P0.x; w.y = P0.y; w.z = rx; w.w = ry; } else { w.x = rx; w.y = ry; w.z = P1.x; w.w = P1.y; }
            *(u32x4*)(orow + 32 * d + 16 * j2 + 8 * hi) = w;
        }
}


__device__ __forceinline__ void swa_unit(LAS unsigned char* lds, const bf16_t* PROJ, bf16_t* Y, const int* positions, const float* qg, const float* sinks, int b, int n, int kvh) {
    int tid_ = threadIdx.x; asm volatile("" : "+v"(tid_));
    asm volatile("" : "+s"(qg), "+s"(sinks));
    const int tid = tid_, lane = tid & 63, wid = __builtin_amdgcn_readfirstlane(tid >> 6), r32 = lane & 31, hi = lane >> 5, w4 = wid & 3;
    constexpr int SLOT = 16384, KB_ = 8192;
    LAS float* poskf = (LAS float*)(lds + 4 * SLOT);
    const int t_begin = (n == 0) ? 2 : 0;
    const long key0 = (long)b * SEQ + 128 * (n - 1);
    const bf16_t* Kg = PROJ + key0 * INP + C_KA + kvh * 64; const bf16_t* Vg = PROJ + key0 * INP + C_VA + kvh * 64;
    const unsigned lds0 = (unsigned)(size_t)lds;
    { const unsigned kr_ = (unsigned)(lane >> 3), kc_ = ((unsigned)(lane & 7) ^ kr_ ^ (unsigned)((wid >> 1) & 1));
      const unsigned ko = kr_ * (unsigned)INP * 2u + kc_ * 16u, vo = ((unsigned)(lane >> 2) * (unsigned)INP + (unsigned)(lane & 3) * 8u) * 2u;
      for (int t = t_begin; t < 4; ++t) {
          at_glds16((const char*)Kg + ((size_t)(t * 64 + 8 * wid) * INP) * 2 + ko, (unsigned)__builtin_amdgcn_readfirstlane((int)(lds0 + (unsigned)(t * SLOT + wid * 1024))));
          at_glds16((const char*)Vg + (((size_t)(t * 64 + (wid & 3) * 16)) * INP + (wid >> 2) * 32) * 2 + vo, (unsigned)__builtin_amdgcn_readfirstlane((int)(lds0 + (unsigned)(t * SLOT + KB_ + wid * 1024)))); }
      if (tid < 256) poskf[tid] = (n == 0 && tid < 128) ? 0.f : (float)positions[key0 + tid]; }
    unsigned kro[4];
#pragma unroll
    for (int j = 0; j < 4; ++j) kro[j] = (unsigned)((r32 >> 3) * 1024 + (r32 & 7) * 128) + (((unsigned)(2 * j + hi) ^ (unsigned)(r32 & 7) ^ (unsigned)((r32 >> 4) & 1)) * 16u);
    const int voff = ((4 * hi + ((lane & 15) >> 2)) * 64) + (((lane >> 4) & 1) * 32) + ((lane & 3) * 8);
    const size_t tok0 = (size_t)b * SEQ + 128 * n + 32 * w4;
    const float pos_qf = (float)positions[tok0 + r32];
    const int qloc = 32 * w4 + r32;
    const int tlo = (w4 < 2) ? t_begin : (t_begin > 1 ? t_begin : 1), thi = (w4 < 2) ? 2 : 3;
    float sk4[4];
#pragma unroll
    for (int i = 0; i < 4; ++i) sk4[i] = sinks[kvh * 8 + i * 2 + (wid >> 2)];
    bf16x8 qn[4];
    { const bf16_t* qw = PROJ + tok0 * INP + C_QA + (kvh * 8 + (wid >> 2)) * 64;
#pragma unroll
      for (int s = 0; s < 4; ++s) qn[s] = *(const bf16x8*)(qw + (size_t)r32 * INP + 16 * s + 8 * hi); }
#pragma unroll 1
    for (int hp = 0; hp < 4; ++hp) {
        const int head = kvh * 8 + hp * 2 + (wid >> 2);
        bf16x8 qf[4];
#pragma unroll
        for (int s = 0; s < 4; ++s) qf[s] = qn[s];
        if (hp < 3) { const bf16_t* qw = PROJ + tok0 * INP + C_QA + (head + 2) * 64;
#pragma unroll
            for (int s = 0; s < 4; ++s) qn[s] = *(const bf16x8*)(qw + (size_t)r32 * INP + 16 * s + 8 * hi); }
        { const float* qg2 = qg; asm volatile("" : "+s"(qg2)); qseg_norm<0, 4>(qf, qg2, QS_SWA, hi); }
        const float slope2 = __builtin_amdgcn_exp2f(-0.5f * (float)(head + 1)) * LOG2E, sink2 = ((hp == 0) ? sk4[0] : (hp == 1) ? sk4[1] : (hp == 2) ? sk4[2] : sk4[3]) * LOG2E;
        if (hp == 0) { asm volatile("s_waitcnt vmcnt(0) lgkmcnt(0)" ::: "memory"); __builtin_amdgcn_s_barrier(); asm volatile("" ::: "memory"); }
        f32x16 o[2];
#pragma unroll
        for (int d = 0; d < 2; ++d)
#pragma unroll
            for (int r = 0; r < 16; ++r) o[d][r] = 0.f;
        float m_run = sink2, l_run = (hi == 0) ? 1.f : 0.f;
#pragma unroll 1
        for (int t = tlo; t <= thi; ++t) {
            const LAS unsigned char* kb = lds + t * SLOT;
            const bool n0 = (2 * t >= w4) && (2 * t <= w4 + 4), n1 = (2 * t + 1 >= w4) && (2 * t + 1 <= w4 + 4);
            f32x16 p0, p1;
#pragma unroll
            for (int r = 0; r < 16; ++r) { p0[r] = 0.f; p1[r] = 0.f; }
            bf16x8 ka[4][2];
#pragma unroll
            for (int s4 = 0; s4 < 4; ++s4) { ka[s4][0] = *(const LAS bf16x8*)(kb + kro[s4]); ka[s4][1] = *(const LAS bf16x8*)(kb + kro[s4] + 4096); }
            if (n0) {
#pragma unroll
                for (int s4 = 0; s4 < 4; ++s4) p0 = __builtin_amdgcn_mfma_f32_32x32x16_bf16(ka[s4][0], qf[s4], p0, 0, 0, 0); }
            if (n1) {
#pragma unroll
                for (int s4 = 0; s4 < 4; ++s4) p1 = __builtin_amdgcn_mfma_f32_32x32x16_bf16(ka[s4][1], qf[s4], p1, 0, 0, 0); }
            const LAS unsigned char* vb = lds + t * SLOT + KB_ + voff;
            s16x4 va[2][4][2];
#pragma unroll
            for (int d = 0; d < 2; ++d)
#pragma unroll
                for (int ks = 0; ks < 4; ++ks) {
                    va[d][ks][0] = __builtin_bit_cast(s16x4, __builtin_amdgcn_ds_read_tr16_b64_v4i16((LAS s16x4*)(vb + (d * 4 + ks) * 1024)));
                    va[d][ks][1] = __builtin_bit_cast(s16x4, __builtin_amdgcn_ds_read_tr16_b64_v4i16((LAS s16x4*)(vb + (d * 4 + ks) * 1024 + 512))); }
            const int qk0 = 128 + qloc - t * 64 - 4 * hi;
            float mx = -1e30f;
            if (n0) {
                if (2 * t == w4 || 2 * t == w4 + 4) {
#pragma unroll
                    for (int r = 0; r < 16; ++r) {
                        const int kl = (r & 3) + 8 * (r >> 2), ki0 = t * 64 + 4 * hi + kl;
                        const float b0 = fmaf(-slope2, fabsf(pos_qf - poskf[ki0]), p0[r]);
                        p0[r] = ((unsigned)(qk0 - kl) < 128u) ? b0 : -1e30f;
                        mx = fmaxf(mx, p0[r]);
                    }
                } else {
#pragma unroll
                    for (int r = 0; r < 16; ++r) {
                        const int kl = (r & 3) + 8 * (r >> 2), ki0 = t * 64 + 4 * hi + kl;
                        p0[r] = fmaf(-slope2, fabsf(pos_qf - poskf[ki0]), p0[r]);
                        mx = fmaxf(mx, p0[r]);
                    }
                } }
            if (n1) {
                if (2 * t + 1 == w4 || 2 * t + 1 == w4 + 4) {
#pragma unroll
                    for (int r = 0; r < 16; ++r) {
                        const int kl = (r & 3) + 8 * (r >> 2), ki0 = t * 64 + 4 * hi + kl;
                        const float b1 = fmaf(-slope2, fabsf(pos_qf - poskf[ki0 + 32]), p1[r]);
                        p1[r] = ((unsigned)(qk0 - kl - 32) < 128u) ? b1 : -1e30f;
                        mx = fmaxf(mx, p1[r]);
                    }
                } else {
#pragma unroll
                    for (int r = 0; r < 16; ++r) {
                        const int kl = (r & 3) + 8 * (r >> 2), ki0 = t * 64 + 4 * hi + kl;
                        p1[r] = fmaf(-slope2, fabsf(pos_qf - poskf[ki0 + 32]), p1[r]);
                        mx = fmaxf(mx, p1[r]);
                    }
                } }
            mx = fmaxf(mx, __shfl_xor(mx, 32));
            const float mn = (mx > m_run + 8.0f) ? mx : m_run, alpha = __builtin_amdgcn_exp2f(m_run - mn); m_run = mn;
            float rs = 0.f;
            if (n0) {
#pragma unroll
                for (int r = 0; r < 16; ++r) { p0[r] = __builtin_amdgcn_exp2f(p0[r] - mn); rs += p0[r]; } }
            if (n1) {
#pragma unroll
                for (int r = 0; r < 16; ++r) { p1[r] = __builtin_amdgcn_exp2f(p1[r] - mn); rs += p1[r]; } }
            l_run = l_run * alpha + rs;
            if (__builtin_amdgcn_ballot_w64(alpha != 1.0f) != 0ull) {
#pragma unroll
                for (int d = 0; d < 2; ++d)
#pragma unroll
                    for (int r = 0; r < 16; ++r) o[d][r] *= alpha;
            }
            if (n0) {
                u32x4 pw[2];
#pragma unroll
                for (int e = 0; e < 4; ++e) { pw[0][e] = cvtpk(p0[2 * e], p0[2 * e + 1]); pw[1][e] = cvtpk(p0[8 + 2 * e], p0[8 + 2 * e + 1]); }
#pragma unroll
                for (int d = 0; d < 2; ++d)
#pragma unroll
                    for (int ks = 0; ks < 2; ++ks) {
                        const bf16x8 vf = (bf16x8){va[d][ks][0][0], va[d][ks][0][1], va[d][ks][0][2], va[d][ks][0][3], va[d][ks][1][0], va[d][ks][1][1], va[d][ks][1][2], va[d][ks][1][3]};
                        o[d] = __builtin_amdgcn_mfma_f32_32x32x16_bf16(vf, __builtin_bit_cast(bf16x8, pw[ks]), o[d], 0, 0, 0); } }
            if (n1) {
                u32x4 pw[2];
#pragma unroll
                for (int e = 0; e < 4; ++e) { pw[0][e] = cvtpk(p1[2 * e], p1[2 * e + 1]); pw[1][e] = cvtpk(p1[8 + 2 * e], p1[8 + 2 * e + 1]); }
#pragma unroll
                for (int d = 0; d < 2; ++d)
#pragma unroll
                    for (int ks = 2; ks < 4; ++ks) {
                        const bf16x8 vf = (bf16x8){va[d][ks][0][0], va[d][ks][0][1], va[d][ks][0][2], va[d][ks][0][3], va[d][ks][1][0], va[d][ks][1][1], va[d][ks][1][2], va[d][ks][1][3]};
                        o[d] = __builtin_amdgcn_mfma_f32_32x32x16_bf16(vf, __builtin_bit_cast(bf16x8, pw[ks - 2]), o[d], 0, 0, 0); } }
        }
        const float lt = l_run + __shfl_xor(l_run, 32);
        const float inv = __builtin_amdgcn_rcpf(lt);
        bf16_t* orow = Y + (tok0 + r32) * DM + head * 64;
#pragma unroll
        for (int d = 0; d < 2; ++d)
#pragma unroll
            for (int j2 = 0; j2 < 2; ++j2) {
                u32x2 P0, P1;
                P0.x = cvtpk(o[d][8 * j2] * inv, o[d][8 * j2 + 1] * inv); P0.y = cvtpk(o[d][8 * j2 + 2] * inv, o[d][8 * j2 + 3] * inv);
                P1.x = cvtpk(o[d][8 * j2 + 4] * inv, o[d][8 * j2 + 5] * inv); P1.y = cvtpk(o[d][8 * j2 + 6] * inv, o[d][8 * j2 + 7] * inv);
                const unsigned sx = hi ? P0.x : P1.x, sy = hi ? P0.y : P1.y;
                const unsigned rx = (unsigned)__shfl_xor((int)sx, 32), ry = (unsigned)__shfl_xor((int)sy, 32);
                u32x4 w;
                if (hi == 0) { w.x = P0.x; w.y = P0.y; w.z = rx; w.w = ry; } else { w.x = rx; w.y = ry; w.z = P1.x; w.w = P1.y; }
                *(u32x4*)(orow + 32 * d + 16 * j2 + 8 * hi) = w;
            }
    }
    asm volatile("s_waitcnt lgkmcnt(0)" ::: "memory"); __builtin_amdgcn_s_barrier(); asm volatile("" ::: "memory");
}


__device__ __forceinline__ void mem_unit(LAS unsigned char* lds, const bf16_t* PROJ, const bf16_t* KVM, bf16_t* Y, const float* qg, int b, int h, int qq) {
    int tid_ = threadIdx.x; asm volatile("" : "+v"(tid_));
    asm volatile("" : "+s"(qg));
    const int tid = tid_, lane = tid & 63, wid = __builtin_amdgcn_readfirstlane(tid >> 6), r32 = lane & 31, hi = lane >> 5;
    constexpr int SLOT = 32768, KB_ = 16384;
    const bf16_t* Kg = KVM + (size_t)b * MEML * 1024 + h * 128; const bf16_t* Vg = Kg + 512;
    const unsigned lds0 = (unsigned)(size_t)lds;
    { const unsigned kr_ = (unsigned)(lane >> 3), kc_ = ((unsigned)(lane & 7) ^ kr_ ^ (unsigned)((wid >> 1) & 1));
      const unsigned ko = kr_ * 1024u * 2u + kc_ * 16u, vo = ((unsigned)(lane >> 2) * 1024u + (unsigned)(lane & 3) * 8u) * 2u;
      for (int t = 0; t < 4; ++t) {
#pragma unroll
          for (int i = 0; i < 2; ++i) {
              at_glds16((const char*)Kg + ((size_t)(t * 64 + 8 * wid) * 1024 + i * 64) * 2 + ko, (unsigned)__builtin_amdgcn_readfirstlane((int)(lds0 + (unsigned)(t * SLOT + (i * 8 + wid) * 1024))));
              const int p = wid + 8 * i, dblk = p >> 2, ks = p & 3;
              at_glds16((const char*)Vg + (((size_t)(t * 64 + ks * 16)) * 1024 + dblk * 32) * 2 + vo, (unsigned)__builtin_amdgcn_readfirstlane((int)(lds0 + (unsigned)(t * SLOT + KB_ + p * 1024)))); } } }
    unsigned kro[4];
#pragma unroll
    for (int j = 0; j < 4; ++j) kro[j] = (unsigned)((r32 >> 3) * 1024 + (r32 & 7) * 128) + (((unsigned)(2 * j + hi) ^ (unsigned)(r32 & 7) ^ (unsigned)((r32 >> 4) & 1)) * 16u);
    const int voff = ((4 * hi + ((lane & 15) >> 2)) * 64) + (((lane >> 4) & 1) * 32) + ((lane & 3) * 8);
    bf16x8 qn[8];
    { const bf16_t* qw = PROJ + ((size_t)b * SEQ + 256 * (4 * qq) + 32 * wid) * INP + C_QM + h * 128;
#pragma unroll
      for (int s = 0; s < 8; ++s) qn[s] = *(const bf16x8*)(qw + (size_t)r32 * INP + 16 * s + 8 * hi); }
#pragma unroll 1
    for (int pass = 0; pass < 4; ++pass) {
        const size_t tok0 = (size_t)b * SEQ + 256 * (4 * qq + pass) + 32 * wid;
        bf16x8 qf[8];
#pragma unroll
        for (int s = 0; s < 8; ++s) qf[s] = qn[s];
        if (pass < 3) { const bf16_t* qw = PROJ + (tok0 + 256) * INP + C_QM + h * 128;
#pragma unroll
            for (int s = 0; s < 8; ++s) qn[s] = *(const bf16x8*)(qw + (size_t)r32 * INP + 16 * s + 8 * hi); }
        { const float* qg2 = qg; asm volatile("" : "+s"(qg2)); qseg_norm<0, 8>(qf, qg2, QS_MEM, hi); }
        if (pass == 0) { asm volatile("s_waitcnt vmcnt(0) lgkmcnt(0)" ::: "memory"); __builtin_amdgcn_s_barrier(); asm volatile("" ::: "memory"); }
        f32x16 o[4];
#pragma unroll
        for (int d = 0; d < 4; ++d)
#pragma unroll
            for (int r = 0; r < 16; ++r) o[d][r] = 0.f;
        float m_run = -1e30f, l_run = 0.f;
#pragma unroll 1
        for (int t = 0; t < 4; ++t) {
            const LAS unsigned char* kb = lds + t * SLOT;
            const LAS unsigned char* vb = lds + t * SLOT + KB_ + voff;
            f32x16 p0, p1;
#pragma unroll
            for (int r = 0; r < 16; ++r) { p0[r] = 0.f; p1[r] = 0.f; }
            { bf16x8 kf[2][2][2];
#pragma unroll
              for (int s4 = 0; s4 < 2; ++s4) { kf[0][s4][0] = *(const LAS bf16x8*)(kb + kro[s4]); kf[0][s4][1] = *(const LAS bf16x8*)(kb + kro[s4] + 4096); }
#pragma unroll
              for (int g = 0; g < 4; ++g) {
                  if (g + 1 < 4) {
#pragma unroll
                      for (int s4 = 0; s4 < 2; ++s4) { const int s_ = (g + 1) * 2 + s4; kf[(g + 1) & 1][s4][0] = *(const LAS bf16x8*)(kb + kro[s_ & 3] + (s_ >> 2) * 8192); kf[(g + 1) & 1][s4][1] = *(const LAS bf16x8*)(kb + kro[s_ & 3] + (s_ >> 2) * 8192 + 4096); } }
                  __builtin_amdgcn_sched_barrier(0);
#pragma unroll
                  for (int s4 = 0; s4 < 2; ++s4) { p0 = __builtin_amdgcn_mfma_f32_32x32x16_bf16(kf[g & 1][s4][0], qf[g * 2 + s4], p0, 0, 0, 0); p1 = __builtin_amdgcn_mfma_f32_32x32x16_bf16(kf[g & 1][s4][1], qf[g * 2 + s4], p1, 0, 0, 0); }
                  __builtin_amdgcn_sched_barrier(0); } }
            float mx = p0[0];
#pragma unroll
            for (int r = 1; r < 16; ++r) mx = fmaxf(mx, p0[r]);
#pragma unroll
            for (int r = 0; r < 16; ++r) mx = fmaxf(mx, p1[r]);
            mx = fmaxf(mx, __shfl_xor(mx, 32));
            const float mn = (mx > m_run + 8.0f) ? mx : m_run, alpha = __builtin_amdgcn_exp2f(m_run - mn); m_run = mn;
            float rs = 0.f;
#pragma unroll
            for (int r = 0; r < 16; ++r) { p0[r] = __builtin_amdgcn_exp2f(p0[r] - mn); p1[r] = __builtin_amdgcn_exp2f(p1[r] - mn); rs += p0[r] + p1[r]; }
            l_run = l_run * alpha + rs;
            if (__builtin_amdgcn_ballot_w64(alpha != 1.0f) != 0ull) {
#pragma unroll
                for (int d = 0; d < 4; ++d)
#pragma unroll
                    for (int r = 0; r < 16; ++r) o[d][r] *= alpha;
            }
            u32x4 pw[4];
#pragma unroll
            for (int e = 0; e < 4; ++e) { pw[0][e] = cvtpk(p0[2 * e], p0[2 * e + 1]); pw[1][e] = cvtpk(p0[8 + 2 * e], p0[8 + 2 * e + 1]); pw[2][e] = cvtpk(p1[2 * e], p1[2 * e + 1]); pw[3][e] = cvtpk(p1[8 + 2 * e], p1[8 + 2 * e + 1]); }
#pragma unroll
            for (int d = 0; d < 4; ++d) {
                s16x4 va[4][2];
#pragma unroll
                for (int ks = 0; ks < 4; ++ks) {
                    va[ks][0] = __builtin_bit_cast(s16x4, __builtin_amdgcn_ds_read_tr16_b64_v4i16((LAS s16x4*)(vb + (d * 4 + ks) * 1024)));
                    va[ks][1] = __builtin_bit_cast(s16x4, __builtin_amdgcn_ds_read_tr16_b64_v4i16((LAS s16x4*)(vb + (d * 4 + ks) * 1024 + 512))); }
#pragma unroll
                for (int ks = 0; ks < 4; ++ks) {
                    const bf16x8 vf = (bf16x8){va[ks][0][0], va[ks][0][1], va[ks][0][2], va[ks][0][3], va[ks][1][0], va[ks][1][1], va[ks][1][2], va[ks][1][3]};
                    o[d] = __builtin_amdgcn_mfma_f32_32x32x16_bf16(vf, __builtin_bit_cast(bf16x8, pw[ks]), o[d], 0, 0, 0); }
                __builtin_amdgcn_sched_barrier(0); }
        }
        const float lt = l_run + __shfl_xor(l_run, 32);
        const float inv = __builtin_amdgcn_rcpf(lt);
        bf16_t* orow = Y + (tok0 + r32) * DM + 1536 + h * 128;
#pragma unroll
        for (int d = 0; d < 4; ++d)
#pragma unroll
            for (int j2 = 0; j2 < 2; ++j2) {
                u32x2 P0, P1;
                P0.x = cvtpk(o[d][8 * j2] * inv, o[d][8 * j2 + 1] * inv); P0.y = cvtpk(o[d][8 * j2 + 2] * inv, o[d][8 * j2 + 3] * inv);
                P1.x = cvtpk(o[d][8 * j2 + 4] * inv, o[d][8 * j2 + 5] * inv); P1.y = cvtpk(o[d][8 * j2 + 6] * inv, o[d][8 * j2 + 7] * inv);
                const unsigned sx = hi ? P0.x : P1.x, sy = hi ? P0.y : P1.y;
                const unsigned rx = (unsigned)__shfl_xor((int)sx, 32), ry = (unsigned)__shfl_xor((int)sy, 32);
                u32x4 w;
                if (hi == 0) { w.x = P0.x; w.y = P0.y; w.z = rx; w.w = ry; } else { w.x = rx; w.y = ry; w.z = P1.x; w.w = P1.y; }
                *(u32x4*)(orow + 32 * d + 16 * j2 + 8 * hi) = w;
            }
    }
    asm volatile("s_waitcnt lgkmcnt(0)" ::: "memory"); __builtin_amdgcn_s_barrier(); asm volatile("" ::: "memory");
}

constexpr int NPH = 9;
__global__ void __launch_bounds__(512, 2) fwd_kernel(Args args) {
    extern __shared__ __attribute__((aligned(16))) unsigned char lds_raw[];
    LAS unsigned char* lds = (LAS unsigned char*)lds_raw;
    const int tid = threadIdx.x, lane = tid & 63, wave = __builtin_amdgcn_readfirstlane(tid >> 6);
    const int G = gridDim.x, bx = blockIdx.x;
    const int gw = bx * 8 + wave, NGW = G * 8;
    unsigned char* ws = args.ws;
    const float* x = (const float*)args.in[0]; const float* mem = (const float*)args.in[1]; const int* positions = (const int*)args.in[2];
    const float* attn_norm_g = (const float*)args.in[3]; const float* w_in = (const float*)args.in[4];
    const float* swa_q_norm_g = (const float*)args.in[5]; const float* swa_k_norm_g = (const float*)args.in[6]; const float* swa_sinks = (const float*)args.in[7];
    const float* mla_cq_norm_g = (const float*)args.in[8]; const float* mla_ckv_norm_g = (const float*)args.in[9];
    const float* w_uq = (const float*)args.in[10]; const float* w_ukv = (const float*)args.in[11];
    const float* mla_qn_norm_g = (const float*)args.in[12]; const float* mla_qr_norm_g = (const float*)args.in[13];
    const float* mla_kn_norm_g = (const float*)args.in[14]; const float* mla_kr_norm_g = (const float*)args.in[15];
    const float* mem_norm_g = (const float*)args.in[16]; const float* w_mem_kv = (const float*)args.in[17];
    const float* mem_q_norm_g = (const float*)args.in[18]; const float* mem_k_norm_g = (const float*)args.in[19];
    const float* w_out = (const float*)args.in[20]; const float* ffn_norm_g = (const float*)args.in[21];
    const float* w_gate = (const float*)args.in[22]; const float* w_up = (const float*)args.in[23]; const float* w_down = (const float*)args.in[24];
    float* out = args.out;
    unsigned* ctl = (unsigned*)(ws + WS_CTL); float* ssq = (float*)(ws + WS_SSQ); float* ssq_cq = ssq + MTOK; float* ssq_ckv = ssq + 2 * MTOK; float* xrms = (float*)(ws + WS_XRMS); float* ginv = (float*)(ws + WS_GINV);
    bf16_t* WIN = (bf16_t*)(ws + WS_WIN); bf16_t* WUQKV = (bf16_t*)(ws + WS_WUQKV); bf16_t* WMEM = (bf16_t*)(ws + WS_WMEM); bf16_t* WOUT = (bf16_t*)(ws + WS_WOUT);
    bf16_t* WGU = (bf16_t*)(ws + WS_WGU); bf16_t* WDN = (bf16_t*)(ws + WS_WDN);
    bf16_t* XN = (bf16_t*)(ws + WS_XN); bf16_t* HB = XN; bf16_t* Y = (bf16_t*)(ws + WS_Y); bf16_t* MEMN = (bf16_t*)(ws + WS_MEMN); bf16_t* KVM = (bf16_t*)(ws + WS_KVM);
    float* KVMP = (float*)(ws + WS_KVMP); bf16_t* PROJ = (bf16_t*)(ws + WS_PROJ); bf16_t* QKVB = (bf16_t*)(ws + WS_QKVB); bf16_t* ACT = (bf16_t*)(ws + WS_ACT);
    const int lo = args.lo, hi = args.hi;
    cg::grid_group grid = cg::this_grid();
    volatile LAS unsigned* MISC = (volatile LAS unsigned*)(lds + MISC_OFF);
    if (tid < 64) MISC[tid] = 0u;
    __syncthreads();
    XcdBarrier bar; bar.bar = ctl + CW_BAR; bar.x = 0; bar.st = MISC + 8;
    if (hi - lo > 1) bar = xcd_barrier_post(ctl + CW_BAR, MISC + 8);
    if (hi > 1000) grid.sync();
#define IN(k) (lo <= (k) && (k) < hi)
#define SEAM(k) do { if ((k) + 1 < hi) xcd_barrier(bar); } while (0)

    if (IN(0)) {
        LAS unsigned* scr = (LAS unsigned*)(lds + wave * 16384);
        constexpr int I_IN = (DM / 64) * (INW / 64), I_UQ = (512 / 64) * (768 / 64), I_UKV = (512 / 64) * (1024 / 64), I_MEM = (DM / 64) * (1024 / 64), I_OUT = (DM / 64) * (DM / 64),
                      I_G = (DM / 64) * (DFF / 64), I_DN = (DFF / 64) * (DM / 64);
        constexpr int NITEMS = I_IN + I_UQ + I_UKV + I_MEM;
        for (int it = gw; it < NITEMS; it += NGW) {
            int r = it;
            if (r < I_IN) { p0_transpose_item(w_in, DM, INW, WIN, 3, nullptr, scr, r, lane); continue; } r -= I_IN;
            if (r < I_UQ) { p0_transpose_item(w_uq, 512, 768, WUQKV, 0, mla_cq_norm_g, scr, r, lane); continue; } r -= I_UQ;
            if (r < I_UKV) { p0_transpose_item(w_ukv, 512, 1024, WUQKV + (size_t)768 * 512, 0, mla_ckv_norm_g, scr, r, lane); continue; } r -= I_UKV;
            p0_transpose_item(w_mem_kv, DM, 1024, WMEM, 0, nullptr, scr, r, lane, 512);
        }
        for (int i = bx * 512 + tid; i < DM; i += G * 512) ginv[i] = 1.0f / attn_norm_g[i];
        { u32x4* z = (u32x4*)(WIN + (size_t)INW * DM); const int nz = (INP - INW) * DM * 2 / 16; for (int i = bx * 512 + tid; i < nz; i += G * 512) z[i] = (u32x4){0u, 0u, 0u, 0u}; }
        for (int m = 2 * gw; m < MTOK; m += 2 * NGW) rms_row2_to_bf16(x + (size_t)m * DM, x + (size_t)(m + 1) * DM, attn_norm_g, XN + (size_t)m * DM, XN + (size_t)(m + 1) * DM, lane, xrms + m);
        for (int m = 2 * gw; m < MMEM; m += 2 * NGW) rms_row2_to_bf16(mem + (size_t)m * DM, mem + (size_t)(m + 1) * DM, mem_norm_g, MEMN + (size_t)m * INP, MEMN + (size_t)(m + 1) * INP, lane);
        SEAM(0);
    }

    if (IN(1)) {
        pg8::Gemm g{XN, WIN, DM, DM, DM, 1 << 30, 0}; pg8::StaticOrder S; S.init(MTOK, INP, G, bx);
        pg8::EpiInProj E{PROJ, ssq_cq, ssq_ckv, swa_k_norm_g, mla_kr_norm_g, positions};
        pg8::gemm_phase<pg8::EpiInProj, pg8::StaticOrder>(lds, g, S, E);
        SEAM(1);
    }

    if (IN(3)) {
        pg8::Gemm g{PROJ + C_CQ, WUQKV, INP, 512, 512, 3, 512}; pg8::UpMemOrder S; S.init(MTOK, NQKV, G, bx, MEMN, WMEM);
        pg8::EpiUpProj E{QKVB, ssq_cq, ssq_ckv, KVMP, (LAS float*)(lds + MISC_OFF + 4096), mla_kn_norm_g};
        pg8::gemm_phase<pg8::EpiUpProj, pg8::UpMemOrder>(lds, g, S, E);
        SEAM(3);
    }

    if (IN(4)) {
        for (int t = gw; t < MMEM; t += NGW) {
#pragma unroll
            for (int part = 0; part < 2; ++part) { const int col = part * 512 + 8 * lane; float f[8];
#pragma unroll
                for (int i = 0; i < 8; ++i) f[i] = 0.f;
#pragma unroll
                for (int ks = 0; ks < 4; ++ks) { const float* p = KVMP + ((size_t)ks * MMEM + t) * 1024 + col; const f32x4 a = *(const f32x4*)p, b = *(const f32x4*)(p + 4);
                    f[0] += a[0]; f[1] += a[1]; f[2] += a[2]; f[3] += a[3]; f[4] += b[0]; f[5] += b[1]; f[6] += b[2]; f[7] += b[3]; }
                if (part == 0) { float ss = 0.f;
#pragma unroll
                    for (int i = 0; i < 8; ++i) ss += f[i] * f[i];
                    const float rstd = 1.0f / sqrtf(group_sum<16>(ss) * (1.0f / 128) + EPS);
#pragma unroll
                    for (int i = 0; i < 8; ++i) f[i] = f[i] * rstd * mem_k_norm_g[8 * (lane & 15) + i]; }
                *(u32x4*)(KVM + (size_t)t * 1024 + col) = pack8(f); }
        }
        SEAM(4);
    }

    if (IN(5)) {
        LAS unsigned* uq = (LAS unsigned*)(lds + MISC_OFF);
        for (;;) {
            if (tid == 0) uq[0] = atomicAdd(ctl, 1u);
            __syncthreads();
            const int u = __builtin_amdgcn_readfirstlane((int)uq[0]) + args.att_lo;
            __syncthreads();
            if (u >= args.att_hi) break;
            const int r32 = lane & 31;
            if (u < N_MLA_UNITS) {
                const int qb = 15 - (u >> 4), bh = u & 15, b = bh >> 2, h = bh & 3;
                const size_t tok0 = (size_t)b * SEQ + 256 * qb + 32 * wave;
                const int qabs = 256 * qb + 32 * wave + r32;
                attn_unit<128, 64, 128, 1>(lds, QKVB + tok0 * NQKV + h * 192, NQKV, QKVB + (size_t)b * SEQ * NQKV + 768 + h * 256, NQKV, PROJ + (size_t)b * SEQ * INP + C_KR, INP,
                                           QKVB + (size_t)b * SEQ * NQKV + 768 + h * 256 + 128, NQKV, Y + tok0 * DM + 1024 + h * 128, DM, 0, 4 * qb + 4,
                                           qabs, (256 * qb + 32 * wave + 31) >> 6, 0, 0.f, 0.f, positions[tok0 + r32], positions, false, mla_qn_norm_g, mla_qr_norm_g);
            } else if (u < N_MLA_UNITS + N_MEM_UNITS) {
                const int v = u - N_MLA_UNITS, qq = v & 3, bh = v >> 2, b = bh >> 2, h = bh & 3;
                mem_unit(lds, PROJ, KVM, Y, mem_q_norm_g, b, h, qq);
            } else if (u >= N_ATT_UNITS) {
                LAS unsigned* scr = (LAS unsigned*)(lds + wave * 16384);
                int lane2 = lane; asm volatile("" : "+v"(lane2));
                int r = (u - N_ATT_UNITS) * 8 + wave;
                const float* W; bf16_t* WT; int K_, N_, mode; const float* ksc = nullptr;
                if (r < CV_OUT) { W = w_out; WT = WOUT; K_ = DM; N_ = DM; mode = 0; }
                else if ((r -= CV_OUT) < CV_G) { W = w_gate; WT = WGU; K_ = DM; N_ = DFF; mode = 1; ksc = ffn_norm_g; }
                else if ((r -= CV_G) < CV_G) { W = w_up; WT = WGU; K_ = DM; N_ = DFF; mode = 2; ksc = ffn_norm_g; }
                else { r -= CV_G; W = w_down; WT = WDN; K_ = DFF; N_ = DM; mode = 0; }
                p0_transpose_item(W, K_, N_, WT, mode, ksc, scr, r, lane2);
            } else {
                const int v = u - N_MLA_UNITS - N_MEM_UNITS, kvh = v & 1, n = (v >> 1) & 31, b = v >> 6;
                swa_unit(lds, PROJ, Y, positions, swa_q_norm_g, swa_sinks, b, n, kvh);
            }
        }
        SEAM(5);
    }

    if (IN(6)) {
        pg8::Gemm g{Y, WOUT, DM, DM, DM, 1 << 30, 0}; pg8::StaticOrder S; S.init(MTOK, DM, G, bx);
        pg8::EpiOutProj E{XN, xrms, ginv, HB, ssq};
        pg8::gemm_phase<pg8::EpiOutProj, pg8::StaticOrder>(lds, g, S, E);
        SEAM(6);
    }

    if (IN(7)) {
        pg8::Gemm g{HB, WGU, DM, DM, DM, 1 << 30, 0}; pg8::StaticOrder S; S.init(MTOK, 2 * DFF, G, bx);
        pg8::EpiSwiGLU E{ACT, ssq};
        pg8::gemm_phase<pg8::EpiSwiGLU, pg8::StaticOrder>(lds, g, S, E);
        SEAM(7);
    }

    if (IN(8)) {
        pg8::Gemm g{ACT, WDN, DFF, DFF, DFF, 1 << 30, 0}; pg8::StaticOrder S; S.init(MTOK, DM, G, bx);
        pg8::EpiDown E{out, HB};
        pg8::gemm_phase<pg8::EpiDown, pg8::StaticOrder>(lds, g, S, E);
    }
#undef IN
#undef SEAM
}

extern "C" void kernel_launch(void* const* d_in, const int* in_sizes, int n_in, void* d_out, int out_size, void* d_ws, size_t ws_size, hipStream_t stream) {
    static int grid = 0;
    if (grid == 0) {
        if (n_in != 25 || out_size != MTOK * DM || ws_size < WS_END) { fprintf(stderr, "kernel_launch: unexpected shapes (n_in %d, out %d, ws %zu < %zu)\n", n_in, out_size, ws_size, (size_t)WS_END); grid = -1; return; }
        int dev = 0, cus = 0, per_cu = 0;
        hipGetDevice(&dev); hipDeviceGetAttribute(&cus, hipDeviceAttributeMultiprocessorCount, dev);
        if (hipFuncSetAttribute((const void*)fwd_kernel, hipFuncAttributeMaxDynamicSharedMemorySize, LDS_BYTES) != hipSuccess) { fprintf(stderr, "kernel_launch: hipFuncSetAttribute failed\n"); grid = -1; return; }
        if (hipOccupancyMaxActiveBlocksPerMultiprocessor(&per_cu, (const void*)fwd_kernel, 512, LDS_BYTES) != hipSuccess || per_cu < 1) { fprintf(stderr, "kernel_launch: occupancy query says %d\n", per_cu); per_cu = 1; }
        (void)hipGetLastError();
        grid = cus;
        if (grid < 32) grid = 32;
    }
    if (grid < 0) return;
    if (hipMemsetAsync((char*)d_ws + WS_CTL, 0, CTL_ZERO_BYTES, stream) != hipSuccess) { fprintf(stderr, "kernel_launch: hipMemsetAsync failed\n"); return; }
    Args a{};
    for (int i = 0; i < 25; ++i) a.in[i] = d_in[i];
    a.out = (float*)d_out; a.ws = (unsigned char*)d_ws; a.att_lo = 0; a.att_hi = N_QUEUE_UNITS;
#if N_LAUNCHES == 1
    a.lo = 0; a.hi = NPH;
    void* kargs[] = {&a};
    hipError_t e = hipLaunchCooperativeKernel((const void*)fwd_kernel, dim3(grid), dim3(512), kargs, LDS_BYTES, stream);
    if (e != hipSuccess) fprintf(stderr, "kernel_launch: cooperative launch failed: %s (grid %d)\n", hipGetErrorString(e), grid);
#else
    for (int p = 0; p < NPH; ++p) {
        a.lo = p; a.hi = p + 1;
        hipLaunchKernelGGL(fwd_kernel, dim3(grid), dim3(512), LDS_BYTES, stream, a);
#ifdef PROBE_REPEAT
        if (p == PROBE_REPEAT) { Args a2 = a;
#ifdef PROBE_ATT_LO
            a2.att_lo = PROBE_ATT_LO; a2.att_hi = PROBE_ATT_HI;
#endif
            for (int rep = 0; rep < PROBE_NREP; ++rep) { (void)hipMemsetAsync(d_ws, 0, 256, stream); hipLaunchKernelGGL(fwd_kernel, dim3(grid), dim3(512), LDS_BYTES, stream, a2); } }
#endif
    }
#endif
}
```

```cpp
#include <hip/hip_runtime.h>
#include <hip/hip_cooperative_groups.h>
#include <cstdio>
#include <cstdint>
namespace cg = cooperative_groups;

#ifndef N_LAUNCHES
#define N_LAUNCHES 1
#endif

#define LAS __attribute__((address_space(3)))
typedef unsigned short bf16_t;
typedef short bf16x8 __attribute__((ext_vector_type(8)));
typedef short s16x4 __attribute__((ext_vector_type(4)));
typedef float f32x4 __attribute__((ext_vector_type(4)));
typedef float f32x16 __attribute__((ext_vector_type(16)));
typedef unsigned u32x4 __attribute__((ext_vector_type(4)));
typedef unsigned u32x2 __attribute__((ext_vector_type(2)));
typedef float f32x2_t __attribute__((ext_vector_type(2)));
typedef __bf16 bf16x2_t __attribute__((ext_vector_type(2)));

constexpr int BATCH = 4, SEQ = 4096, MTOK = BATCH * SEQ, DM = 2048, MEML = 256, MMEM = BATCH * MEML;
constexpr int INW = 2880, INP = 3072, DFF = 5632;
constexpr int C_QA = 0, C_KA = 1024, C_VA = 1152, C_CQ = 1280, C_CKV = 1792, C_KR = 2304, C_QM = 2368;
constexpr int NQKV = 1792;
constexpr float EPS = 1e-6f;
constexpr float LOG2E = 1.4426950408889634f;
constexpr float QS_SWA = 0.125f * LOG2E;
constexpr float QS_MLA = 0.07216878364870322f * LOG2E;
constexpr float QS_MEM = 0.08838834764831845f * LOG2E;

constexpr size_t al256(size_t x) { return (x + 255) & ~(size_t)255; }
constexpr size_t WS_CTL = 0;
constexpr size_t WS_SSQ = 32768;
constexpr size_t CTL_ZERO_BYTES = WS_SSQ + (size_t)3 * MTOK * 4;
constexpr int CW_BAR = 4096;
constexpr size_t WS_XRMS = al256(WS_SSQ + (size_t)3 * MTOK * 4);
constexpr size_t WS_GINV = WS_XRMS + (size_t)MTOK * 4;
constexpr size_t WS_WIN = al256(WS_GINV + (size_t)DM * 4);
constexpr size_t WS_WUQKV = WS_WIN + (size_t)INP * DM * 2;
constexpr size_t WS_WMEM = WS_WUQKV + (size_t)NQKV * 512 * 2;
constexpr size_t WS_WOUT = WS_WMEM + (size_t)1024 * DM * 2;
constexpr size_t WS_WGU = WS_WOUT + (size_t)DM * DM * 2;
constexpr size_t WS_WDN = WS_WGU + (size_t)2 * DFF * DM * 2;
constexpr size_t WS_XN = WS_WDN + (size_t)DM * DFF * 2;
constexpr size_t WS_Y = WS_XN + (size_t)MTOK * DM * 2;
constexpr size_t WS_MEMN = WS_Y + (size_t)MTOK * DM * 2;
constexpr size_t WS_KVM = WS_MEMN + (size_t)MMEM * INP * 2;
constexpr size_t WS_KVMP = WS_KVM + (size_t)MMEM * 1024 * 2;
constexpr size_t WS_BIG = WS_KVMP + (size_t)4 * MMEM * 1024 * 4;
constexpr size_t WS_PROJ = WS_BIG;
constexpr size_t WS_QKVB = WS_PROJ + (size_t)MTOK * INP * 2;
constexpr size_t WS_ACT = WS_BIG;
constexpr size_t WS_END1 = WS_QKVB + (size_t)MTOK * NQKV * 2, WS_END2 = WS_ACT + (size_t)MTOK * DFF * 2;
constexpr size_t WS_END = WS_END1 > WS_END2 ? WS_END1 : WS_END2;
static_assert(WS_END <= (size_t)512 * 1024 * 1024, "workspace map exceeds 512 MiB");

constexpr int RING_BYTES = 131072;
constexpr int MISC_OFF = RING_BYTES;
constexpr int LDS_BYTES = 147456;

__device__ __forceinline__ unsigned cvtpk(float lo, float hi) { f32x2_t v = {lo, hi}; bf16x2_t b = __builtin_convertvector(v, bf16x2_t); return __builtin_bit_cast(unsigned, b); }
__device__ __forceinline__ float bflo(unsigned w) { return __uint_as_float(w << 16); }
__device__ __forceinline__ float bfhi(unsigned w) { return __uint_as_float(w & 0xffff0000u); }
__device__ __forceinline__ float bf1(bf16_t v) { return __uint_as_float(((unsigned)v) << 16); }
__device__ __forceinline__ void unpack8(const u32x4 w, float (&f)[8]) {
    f[0] = bflo(w.x); f[1] = bfhi(w.x); f[2] = bflo(w.y); f[3] = bfhi(w.y); f[4] = bflo(w.z); f[5] = bfhi(w.z); f[6] = bflo(w.w); f[7] = bfhi(w.w); }
__device__ __forceinline__ u32x4 pack8(const float (&f)[8]) { u32x4 w; w.x = cvtpk(f[0], f[1]); w.y = cvtpk(f[2], f[3]); w.z = cvtpk(f[4], f[5]); w.w = cvtpk(f[6], f[7]); return w; }
template <int W> __device__ __forceinline__ float group_sum(float v) {
#pragma unroll
    for (int o = 1; o < W; o <<= 1) v += __shfl_xor(v, o);
    return v; }

__device__ __forceinline__ void rope_cs(int pos, int i, float& c, float& s) {
    const float inv = __builtin_amdgcn_exp2f(-(float)i * (13.287712379549449f / 32.0f));
    const float ang = (float)pos * inv;
    const float n = rintf(ang * 0.15915494309189535f);
    float r = fmaf(-n, 6.28125f, ang); r = fmaf(-n, 1.9353071795864769e-3f, r);
    const float rev = r * 0.15915494309189535f;
    s = __builtin_amdgcn_sinf(rev); c = __builtin_amdgcn_cosf(rev);
}


namespace pg8 {
constexpr int BM = 256, BK = 64, HALF = 128, HTB = HALF * BK * 2, STAGE_BYTES = 8 * HTB, NXCD = 8, WGM = 4;
__host__ __device__ __forceinline__ int lds_byte(int r, int c) { const int st = (r >> 4) * 2 + (c >> 5), rr = r & 15, cc = c & 31, ob = rr * 64 + cc * 2; return st * 1024 + (ob ^ (((ob >> 9) & 1) << 5)); }
__host__ __device__ __forceinline__ void stage_rc(int b, int& R, int& C) { const int st = b / 1024, sb = b % 1024, swz = sb ^ (((sb >> 9) & 1) << 5); R = (st >> 1) * 16 + swz / 64; C = (st & 1) * 32 + (swz % 64) / 2; }
__host__ __device__ __forceinline__ int perm32(int rho) { const int n = rho >> 4, i = rho & 15; return 8 * (i >> 2) + 4 * n + (i & 3); }

struct Unit { int pm, pn, kind, ks; };
struct Gemm { const bf16_t* A; const bf16_t* Bt; int lda, ldb, K, a_split_pn, a_split_off; };

struct StaticOrder {
    int nM, nN, nwg, G, c, rev;
    __device__ void init(int M, int N, int G_, int c_, int rev_ = 0) { nM = M / BM; nN = N / BM; nwg = nM * nN; G = G_; c = c_; rev = rev_; }
    __device__ bool next(int i, Unit& u) const {
        const long L = (long)i * G + c; if (L >= nwg) return false;
        int wgid = (int)L; { const int q = nwg / NXCD, r = nwg % NXCD, xcd = wgid % NXCD, off = wgid / NXCD; wgid = (xcd < r ? xcd * (q + 1) : r * (q + 1) + (xcd - r) * q) + off; }
        const int nig = WGM * nN; int gid = wgid / nig;
        if (rev) { const int q = nwg / NXCD, gpc = q / nig, x = gid / gpc; gid = x * gpc + (gpc - 1 - (gid - x * gpc)); }
        const int fm = gid * WGM, gsz = (nM - fm) < WGM ? (nM - fm) : WGM;
        u.pm = fm + ((wgid % nig) % gsz); u.pn = (wgid % nig) / gsz; u.kind = 0; u.ks = 0; return true;
    }
    __device__ __forceinline__ void ptrs(const Gemm& g, const Unit& u, const char*& a, const char*& b) const {
        a = (const char*)g.A + (size_t)u.pm * (BM * 2) * g.lda + (u.pn >= g.a_split_pn ? (size_t)g.a_split_off * 2 : (size_t)0);
        b = (const char*)g.Bt + (size_t)u.pn * (BM * 2) * g.ldb;
    }
};
struct UpMemOrder {
    StaticOrder base; const bf16_t* memn; const bf16_t* wmems;
    __device__ void init(int M, int N, int G_, int c_, const bf16_t* memn_, const bf16_t* wmems_) { base.init(M, N, G_, c_); memn = memn_; wmems = wmems_; }
    __device__ bool next(int i, Unit& u) const {
        if (base.next(i, u)) return true;
        const long L = (long)i * base.G + base.c - base.nwg; if (L >= 64) return false;
        const int q = (int)L, tile = q >> 2; u.kind = 1; u.ks = q & 3; u.pm = tile >> 2; u.pn = tile & 3; return true;
    }
    __device__ __forceinline__ void ptrs(const Gemm& g, const Unit& u, const char*& a, const char*& b) const {
        if (u.kind == 0) { base.ptrs(g, u, a, b); return; }
        a = (const char*)memn + ((size_t)u.pm * BM * g.lda + (size_t)u.ks * 512) * 2;
        b = (const char*)wmems + ((size_t)u.ks * 1024 * 512 + (size_t)u.pn * BM * 512) * 2;
    }
};

struct EpiBf16 {
    static constexpr bool PERM = true; static constexpr int NPRE = 0;
    bf16_t* O; int ldc;
    __device__ __forceinline__ void operator()(const f32x4 (&acc)[2][2][4][2], const Unit& u, int wr, int wc, int fr, int fq) const {
        const int row0 = u.pm * BM + wr * 64 + fr, col0 = u.pn * BM + wc * 32 + 8 * fq;
#pragma unroll
        for (int ai = 0; ai < 2; ++ai)
#pragma unroll
            for (int m = 0; m < 4; ++m) { bf16_t* rowp = O + (size_t)(row0 + ai * HALF + m * 16) * ldc + col0;
#pragma unroll
                for (int bj = 0; bj < 2; ++bj) { const f32x4 v0 = acc[ai][bj][m][0], v1 = acc[ai][bj][m][1];
                    u32x4 w; w.x = cvtpk(v0[0], v0[1]); w.y = cvtpk(v0[2], v0[3]); w.z = cvtpk(v1[0], v1[1]); w.w = cvtpk(v1[2], v1[3]);
                    *(u32x4*)(rowp + bj * HALF) = w; } }
    }
};
struct EpiInProj {
    static constexpr bool PERM = true; static constexpr int NPRE = 0;
    bf16_t* O; float* ssq_cq; float* ssq_ckv; const float* g_ka; const float* g_kr; const int* positions;
    __device__ __forceinline__ void operator()(const f32x4 (&acc)[2][2][4][2], const Unit& u, int wr, int wc, int fr, int fq) const {
        const int row0 = u.pm * BM + wr * 64 + fr;
        const int pn = u.pn;
        if (pn == 4 || pn == 9) {
            const int cbase = pn * BM + 64 * wc + 8 * fq;
            const bool norm = (pn == 4) ? (wc < 2) : (wc == 0);
            const float* gg = (pn == 4) ? g_ka : g_kr;
            float gv[2][8];
#pragma unroll
            for (int bj = 0; bj < 2; ++bj)
#pragma unroll
                for (int i = 0; i < 8; ++i) gv[bj][i] = norm ? gg[32 * bj + 8 * fq + i] : 1.0f;
#pragma unroll
            for (int ai = 0; ai < 2; ++ai)
#pragma unroll
                for (int m = 0; m < 4; ++m) { const int row = row0 + ai * HALF + m * 16;
                    float v[2][8];
#pragma unroll
                    for (int bj = 0; bj < 2; ++bj)
#pragma unroll
                        for (int n = 0; n < 2; ++n)
#pragma unroll
                            for (int e = 0; e < 4; ++e) v[bj][4 * n + e] = acc[ai][bj][m][n][e];
                    {
                        float ss = 0.f;
#pragma unroll
                        for (int bj = 0; bj < 2; ++bj)
#pragma unroll
                            for (int i = 0; i < 8; ++i) ss += v[bj][i] * v[bj][i];
                        ss += __shfl_xor(ss, 16); ss += __shfl_xor(ss, 32);
                        const float rstd = norm ? __builtin_amdgcn_rsqf(ss * (1.0f / 64) + EPS) : 1.0f;
#pragma unroll
                        for (int bj = 0; bj < 2; ++bj)
#pragma unroll
                            for (int i = 0; i < 8; ++i) v[bj][i] *= rstd * gv[bj][i];
                        const bool rope = norm && (pn == 9);
                        const int pos = positions[row];
#pragma unroll
                        for (int i = 0; i < 8; ++i) { float c_, s_; rope_cs(pos, 8 * fq + i, c_, s_); if (!rope) { c_ = 1.0f; s_ = 0.0f; } const float x1 = v[0][i], x2 = v[1][i]; v[0][i] = x1 * c_ - x2 * s_; v[1][i] = x1 * s_ + x2 * c_; }
                    }
#pragma unroll
                    for (int bj = 0; bj < 2; ++bj) *(u32x4*)(O + (size_t)row * INP + cbase + 32 * bj) = pack8(v[bj]);
                }
            return;
        }
        const int col0 = pn * BM + wc * 32 + 8 * fq;
        float* ssq = (pn == 5 || pn == 6) ? ssq_cq : ((pn == 7 || pn == 8) ? ssq_ckv : nullptr);
#pragma unroll
        for (int ai = 0; ai < 2; ++ai)
#pragma unroll
            for (int m = 0; m < 4; ++m) { const int row = row0 + ai * HALF + m * 16; bf16_t* rowp = O + (size_t)row * INP + col0; float s = 0.f;
#pragma unroll
                for (int bj = 0; bj < 2; ++bj) { const f32x4 v0 = acc[ai][bj][m][0], v1 = acc[ai][bj][m][1];
                    u32x4 w; w.x = cvtpk(v0[0], v0[1]); w.y = cvtpk(v0[2], v0[3]); w.z = cvtpk(v1[0], v1[1]); w.w = cvtpk(v1[2], v1[3]);
                    *(u32x4*)(rowp + bj * HALF) = w;
                    s += (v0[0] * v0[0] + v0[1] * v0[1]) + (v0[2] * v0[2] + v0[3] * v0[3]) + (v1[0] * v1[0] + v1[1] * v1[1]) + (v1[2] * v1[2] + v1[3] * v1[3]); }
                if (ssq) { s += __shfl_xor(s, 16); s += __shfl_xor(s, 32); if (fq == 0) atomicAdd(ssq + row, s); } }
    }
};
struct EpiUpProj {
    static constexpr bool PERM = true; static constexpr int NPRE = 0;
    bf16_t* O; const float* ssq_cq; const float* ssq_ckv; float* kvmp; LAS float* xch; const float* g_kn;
    __device__ __forceinline__ void operator()(const f32x4 (&acc)[2][2][4][2], const Unit& u, int wr, int wc, int fr, int fq) const {
        const int row0 = u.pm * BM + wr * 64 + fr, col0 = u.pn * BM + wc * 32 + 8 * fq;
        if (u.kind == 1) {
#pragma unroll
            for (int ai = 0; ai < 2; ++ai)
#pragma unroll
                for (int m = 0; m < 4; ++m) { float* rowp = kvmp + ((size_t)u.ks * MMEM + row0 + ai * HALF + m * 16) * 1024 + col0;
#pragma unroll
                    for (int bj = 0; bj < 2; ++bj) { *(f32x4*)(rowp + bj * HALF) = acc[ai][bj][m][0]; *(f32x4*)(rowp + bj * HALF + 4) = acc[ai][bj][m][1]; } }
            return;
        }
        const float* ssq = (u.pn < 3) ? ssq_cq : ssq_ckv;
        float rstd[2][4];
#pragma unroll
        for (int ai = 0; ai < 2; ++ai)
#pragma unroll
            for (int m = 0; m < 4; ++m) rstd[ai][m] = __builtin_amdgcn_rsqf(ssq[row0 + ai * HALF + m * 16] * (1.0f / 512) + EPS);
        if (u.pn >= 3) {
#pragma unroll
            for (int ai = 0; ai < 2; ++ai)
#pragma unroll
                for (int m = 0; m < 4; ++m) { const f32x4 a0 = acc[ai][0][m][0] * rstd[ai][m], a1 = acc[ai][0][m][1] * rstd[ai][m];
                    float s = (a0[0] * a0[0] + a0[1] * a0[1]) + (a0[2] * a0[2] + a0[3] * a0[3]) + (a1[0] * a1[0] + a1[1] * a1[1]) + (a1[2] * a1[2] + a1[3] * a1[3]);
                    s += __shfl_xor(s, 16); s += __shfl_xor(s, 32);
                    if (fq == 0) xch[(ai * HALF + wr * 64 + m * 16 + fr) * 4 + wc] = s; }
            asm volatile("s_waitcnt lgkmcnt(0)" ::: "memory"); __builtin_amdgcn_s_barrier(); asm volatile("" ::: "memory");
            float gk[8];
#pragma unroll
            for (int i = 0; i < 8; ++i) gk[i] = g_kn[32 * wc + 8 * fq + i];
#pragma unroll
            for (int ai = 0; ai < 2; ++ai)
#pragma unroll
                for (int m = 0; m < 4; ++m) { const int row = row0 + ai * HALF + m * 16; bf16_t* rowp = O + (size_t)row * NQKV + col0;
                    const f32x4 ps = *(const LAS f32x4*)(xch + (ai * HALF + wr * 64 + m * 16 + fr) * 4);
                    const float r2 = __builtin_amdgcn_rsqf(((ps[0] + ps[1]) + (ps[2] + ps[3])) * (1.0f / 128) + EPS) * rstd[ai][m];
                    { const f32x4 v0 = acc[ai][0][m][0] * r2, v1 = acc[ai][0][m][1] * r2;
                      u32x4 w; w.x = cvtpk(v0[0] * gk[0], v0[1] * gk[1]); w.y = cvtpk(v0[2] * gk[2], v0[3] * gk[3]); w.z = cvtpk(v1[0] * gk[4], v1[1] * gk[5]); w.w = cvtpk(v1[2] * gk[6], v1[3] * gk[7]);
                      *(u32x4*)(rowp) = w; }
                    { const f32x4 v0 = acc[ai][1][m][0] * rstd[ai][m], v1 = acc[ai][1][m][1] * rstd[ai][m];
                      u32x4 w; w.x = cvtpk(v0[0], v0[1]); w.y = cvtpk(v0[2], v0[3]); w.z = cvtpk(v1[0], v1[1]); w.w = cvtpk(v1[2], v1[3]);
                      *(u32x4*)(rowp + HALF) = w; } }
            return;
        }
#pragma unroll
        for (int ai = 0; ai < 2; ++ai)
#pragma unroll
            for (int m = 0; m < 4; ++m) { const int row = row0 + ai * HALF + m * 16; bf16_t* rowp = O + (size_t)row * NQKV + col0;
#pragma unroll
                for (int bj = 0; bj < 2; ++bj) { const f32x4 v0 = acc[ai][bj][m][0] * rstd[ai][m], v1 = acc[ai][bj][m][1] * rstd[ai][m];
                    u32x4 w; w.x = cvtpk(v0[0], v0[1]); w.y = cvtpk(v0[2], v0[3]); w.z = cvtpk(v1[0], v1[1]); w.w = cvtpk(v1[2], v1[3]);
                    *(u32x4*)(rowp + bj * HALF) = w; } }
    }
};
struct EpiOutProj {
    static constexpr bool PERM = true; static constexpr int NPRE = 0;
    const bf16_t* xn; const float* xrms; const float* ginv; bf16_t* hb; float* ssq;
    __device__ __forceinline__ void operator()(const f32x4 (&acc)[2][2][4][2], const Unit& u, int wr, int wc, int fr, int fq) const {
        const int row0 = u.pm * BM + wr * 64 + fr, col0 = u.pn * BM + wc * 32 + 8 * fq;
        f32x4 gi[2][2];
#pragma unroll
        for (int bj = 0; bj < 2; ++bj) { gi[bj][0] = *(const f32x4*)(ginv + col0 + bj * HALF); gi[bj][1] = *(const f32x4*)(ginv + col0 + bj * HALF + 4); }
#pragma unroll
        for (int ai = 0; ai < 2; ++ai) {
            u32x4 xv[4][2]; float rm[4];
#pragma unroll
            for (int m = 0; m < 4; ++m) { const int row = row0 + ai * HALF + m * 16; const size_t off = (size_t)row * DM + col0; rm[m] = xrms[row];
#pragma unroll
                for (int bj = 0; bj < 2; ++bj) xv[m][bj] = *(const u32x4*)(xn + off + bj * HALF); }
            asm volatile("" ::: "memory");
#pragma unroll
            for (int m = 0; m < 4; ++m) { const int row = row0 + ai * HALF + m * 16; const size_t off = (size_t)row * DM + col0; float s = 0.f;
#pragma unroll
                for (int bj = 0; bj < 2; ++bj) { const u32x4 xw = xv[m][bj]; const float r = rm[m];
                    f32x4 x0, x1; x0[0] = bflo(xw.x); x0[1] = bfhi(xw.x); x0[2] = bflo(xw.y); x0[3] = bfhi(xw.y); x1[0] = bflo(xw.z); x1[1] = bfhi(xw.z); x1[2] = bflo(xw.w); x1[3] = bfhi(xw.w);
                    const f32x4 h0 = x0 * (gi[bj][0] * r) + acc[ai][bj][m][0], h1 = x1 * (gi[bj][1] * r) + acc[ai][bj][m][1];
                    u32x4 w; w.x = cvtpk(h0[0], h0[1]); w.y = cvtpk(h0[2], h0[3]); w.z = cvtpk(h1[0], h1[1]); w.w = cvtpk(h1[2], h1[3]);
                    *(u32x4*)(hb + off + bj * HALF) = w;
                    s += (h0[0] * h0[0] + h0[1] * h0[1]) + (h0[2] * h0[2] + h0[3] * h0[3]) + (h1[0] * h1[0] + h1[1] * h1[1]) + (h1[2] * h1[2] + h1[3] * h1[3]); }
                s += __shfl_xor(s, 16); s += __shfl_xor(s, 32);
                if (fq == 0) atomicAdd(ssq + row, s); }
            asm volatile("" ::: "memory");
        }
    }
};
struct EpiSwiGLU {
    static constexpr bool PERM = true; static constexpr int NPRE = 8;
    bf16_t* act; const float* ssq;
    __device__ __forceinline__ void pre(float (&p)[8], const Unit& u, int wr, int wc, int fr, int fq) const {
        const int row0 = u.pm * BM + wr * 64 + fr;
#pragma unroll
        for (int ai = 0; ai < 2; ++ai)
#pragma unroll
            for (int m = 0; m < 4; ++m) p[ai * 4 + m] = ssq[row0 + ai * HALF + m * 16];
    }
    __device__ __forceinline__ void operator()(const f32x4 (&acc)[2][2][4][2], const Unit& u, int wr, int wc, int fr, int fq, const float (&p)[8]) const {
        const int row0 = u.pm * BM + wr * 64 + fr, col0 = u.pn * HALF + wc * 32 + 8 * fq;
        float sq[2][4];
#pragma unroll
        for (int ai = 0; ai < 2; ++ai)
#pragma unroll
            for (int m = 0; m < 4; ++m) sq[ai][m] = p[ai * 4 + m];
#pragma unroll
        for (int ai = 0; ai < 2; ++ai)
#pragma unroll
            for (int m = 0; m < 4; ++m) { const int row = row0 + ai * HALF + m * 16;
                const float rstd = __builtin_amdgcn_rsqf(sq[ai][m] * (1.0f / DM) + EPS), c1 = -rstd * LOG2E, rstd2 = rstd * rstd;
                float a[8];
#pragma unroll
                for (int n = 0; n < 2; ++n) { const f32x4 g4 = acc[ai][0][m][n], u4 = acc[ai][1][m][n], gu = g4 * u4, t4 = g4 * c1; f32x4 r4;
#pragma unroll
                    for (int e = 0; e < 4; ++e) r4[e] = __builtin_amdgcn_rcpf(1.0f + __builtin_amdgcn_exp2f(t4[e]));
                    const f32x4 o4 = gu * (r4 * rstd2);
#pragma unroll
                    for (int e = 0; e < 4; ++e) a[n * 4 + e] = o4[e]; }
                *(u32x4*)(act + (size_t)row * DFF + col0) = pack8(a); }
    }
};
struct EpiDown {
    static constexpr bool PERM = true; static constexpr int NPRE = 0;
    float* out; const bf16_t* hb;
    __device__ __forceinline__ void operator()(const f32x4 (&acc)[2][2][4][2], const Unit& u, int wr, int wc, int fr, int fq) const {
        const int row0 = u.pm * BM + wr * 64 + fr, col0 = u.pn * BM + wc * 32 + 8 * fq;
        u32x4 hw[2][4][2];
#pragma unroll
        for (int ai = 0; ai < 2; ++ai)
#pragma unroll
            for (int m = 0; m < 4; ++m) { const size_t off = (size_t)(row0 + ai * HALF + m * 16) * DM + col0;
#pragma unroll
                for (int bj = 0; bj < 2; ++bj) hw[ai][m][bj] = *(const u32x4*)(hb + off + bj * HALF); }
        asm volatile("" ::: "memory");
#pragma unroll
        for (int ai = 0; ai < 2; ++ai)
#pragma unroll
            for (int m = 0; m < 4; ++m) { const size_t off = (size_t)(row0 + ai * HALF + m * 16) * DM + col0;
#pragma unroll
                for (int bj = 0; bj < 2; ++bj) { const u32x4 w = hw[ai][m][bj];
                    f32x4 h0, h1; h0[0] = bflo(w.x); h0[1] = bfhi(w.x); h0[2] = bflo(w.y); h0[3] = bfhi(w.y); h1[0] = bflo(w.z); h1[1] = bfhi(w.z); h1[2] = bflo(w.w); h1[3] = bfhi(w.w);
                    *(f32x4*)(out + off + bj * HALF) = h0 + acc[ai][bj][m][0]; *(f32x4*)(out + off + bj * HALF + 4) = h1 + acc[ai][bj][m][1]; } }
    }
};

template <class Epi, class Sched, bool ALIGN_EPI = true>
__device__ __forceinline__ void gemm_phase(LAS unsigned char* lds, const Gemm g, const Sched& S, const Epi& E) {
    const int tid = threadIdx.x, wid = __builtin_amdgcn_readfirstlane(tid >> 6), lane = tid & 63, wr = wid >> 2, wc = wid & 3, fr = lane & 15, fq = lane >> 4;
    const int K = g.K, nt = K / BK;
    unsigned voffA[2], voffB[2];
#pragma unroll
    for (int i = 0; i < 2; ++i) { int R, C; stage_rc(tid * 16 + i * 8192, R, C); const int Rb = Epi::PERM ? ((R & ~31) + perm32(R & 31)) : R;
        voffA[i] = (unsigned)(R * g.lda + C) * 2u; voffB[i] = (unsigned)(Rb * g.ldb + C) * 2u; }
    const size_t kstep = (size_t)(BK * 2);
    const size_t hstepA = (size_t)HALF * g.lda * 2, hstepB = (size_t)HALF * g.ldb * 2;
    const unsigned ldsw = (unsigned)wid * 1024u;
    const int aoff = lds_byte(wr * 64 + fr, fq * 8), boff = lds_byte(wc * 32 + fr, fq * 8);
#define PG8_SA(b, h) (((b) * 2 + (h)) * HTB)
#define PG8_SB(b, h) ((4 + (b) * 2 + (h)) * HTB)
#define PG8_STAGE(bufoff, gbase, voff) do { _Pragma("unroll") for (int _i = 0; _i < 2; ++_i) \
        __builtin_amdgcn_global_load_lds((const unsigned*)((const char*)(gbase) + (voff)[_i]), (LAS unsigned*)(lds + (bufoff) + ldsw + _i * 8192), 16, 0, 0); } while (0)
#define PG8_LDA(dst, b, h) do { _Pragma("unroll") for (int m = 0; m < 4; ++m) _Pragma("unroll") for (int k = 0; k < 2; ++k) dst[m][k] = *(const LAS bf16x8*)(lds + PG8_SA(b, h) + aoff + m * 2048 + k * 1024); } while (0)
#define PG8_LDB(dst, b, h) do { _Pragma("unroll") for (int n = 0; n < 2; ++n) _Pragma("unroll") for (int k = 0; k < 2; ++k) dst[n][k] = *(const LAS bf16x8*)(lds + PG8_SB(b, h) + boff + n * 2048 + k * 1024); } while (0)
#define PG8_MMA(ai, bj, At, Bt) do { __builtin_amdgcn_s_setprio(1); _Pragma("unroll") for (int m = 0; m < 4; ++m) _Pragma("unroll") for (int n = 0; n < 2; ++n) _Pragma("unroll") for (int k = 0; k < 2; ++k) \
        acc[ai][bj][m][n] = __builtin_amdgcn_mfma_f32_16x16x32_bf16(Bt[n][k], At[m][k], acc[ai][bj][m][n], 0, 0, 0); __builtin_amdgcn_s_setprio(0); } while (0)
#define PG8_WAIT_V(n) asm volatile("s_waitcnt vmcnt(" #n ")" ::: "memory")
#define PG8_WAIT_L(n) asm volatile("s_waitcnt lgkmcnt(" #n ")" ::: "memory")
#define PG8_BAR __builtin_amdgcn_s_barrier()
#define PG8_SCHED __builtin_amdgcn_sched_barrier(0)
    Unit cur, nxt; int ui = 0;
    if (!S.next(0, cur)) return;
    f32x4 acc[2][2][4][2];
#pragma unroll
    for (int a = 0; a < 2; ++a)
#pragma unroll
        for (int b = 0; b < 2; ++b)
#pragma unroll
            for (int m = 0; m < 4; ++m)
#pragma unroll
                for (int n = 0; n < 2; ++n) acc[a][b][m][n] = (f32x4){0.f, 0.f, 0.f, 0.f};
    bf16x8 At[4][2], B0[2][2], B1[2][2];
    float epf[Epi::NPRE > 0 ? Epi::NPRE : 1]; int epf_pm = -1;
    const char* cA; const char* cB; S.ptrs(g, cur, cA, cB);
    PG8_STAGE(PG8_SB(0, 0), cB, voffB); PG8_STAGE(PG8_SB(0, 1), cB + hstepB, voffB); PG8_STAGE(PG8_SA(0, 0), cA, voffA); PG8_STAGE(PG8_SA(0, 1), cA + hstepA, voffA);
    if (wr == 1) PG8_BAR;
    PG8_WAIT_V(2); PG8_BAR;
    PG8_STAGE(PG8_SB(1, 0), cB + kstep, voffB); PG8_STAGE(PG8_SA(1, 0), cA + kstep, voffA); PG8_STAGE(PG8_SB(1, 1), cB + hstepB + kstep, voffB);
    PG8_WAIT_V(6); PG8_BAR;
    for (;;) {
        const bool has_next = S.next(ui + 1, nxt);
        const char* nA = cA; const char* nB = cB; if (has_next) S.ptrs(g, nxt, nA, nB);
        for (int t = 0; t < nt; t += 2) {
            const bool last = (t == nt - 2);
            if constexpr (Epi::NPRE > 0) { if (last && cur.pm != epf_pm) { E.pre(epf, cur, wr, wc, fr, fq); epf_pm = cur.pm; } }
            const char* a1 = cA + (size_t)(t + 1) * kstep;
            const char* a2 = last ? nA : cA + (size_t)(t + 2) * kstep; const char* b2 = last ? nB : cB + (size_t)(t + 2) * kstep;
            const char* a3 = a2 + kstep; const char* b3 = b2 + kstep;
            PG8_LDB(B0, 0, 0); PG8_LDB(B1, 0, 1); PG8_SCHED; PG8_LDA(At, 0, 0); PG8_STAGE(PG8_SA(1, 1), a1 + hstepA, voffA);
            PG8_WAIT_V(8); PG8_WAIT_L(0); PG8_BAR; PG8_MMA(0, 0, At, B0); PG8_MMA(0, 1, At, B1); PG8_BAR; PG8_SCHED;
            PG8_LDA(At, 0, 1); PG8_STAGE(PG8_SB(0, 0), b2, voffB); PG8_STAGE(PG8_SB(0, 1), b2 + hstepB, voffB); PG8_STAGE(PG8_SA(0, 0), a2, voffA);
            PG8_WAIT_V(8); PG8_WAIT_L(0); PG8_BAR; PG8_MMA(1, 0, At, B0); PG8_MMA(1, 1, At, B1); PG8_BAR; PG8_SCHED;
            PG8_LDB(B0, 1, 0); PG8_LDB(B1, 1, 1); PG8_SCHED; PG8_LDA(At, 1, 0); PG8_STAGE(PG8_SA(0, 1), a2 + hstepA, voffA);
            PG8_WAIT_V(8); PG8_WAIT_L(0); PG8_BAR; PG8_MMA(0, 0, At, B0); PG8_MMA(0, 1, At, B1); PG8_BAR; PG8_SCHED;
            PG8_LDA(At, 1, 1); PG8_STAGE(PG8_SB(1, 0), b3, voffB); PG8_STAGE(PG8_SB(1, 1), b3 + hstepB, voffB); PG8_STAGE(PG8_SA(1, 0), a3, voffA);
            PG8_WAIT_V(8); PG8_WAIT_L(0); PG8_BAR; PG8_MMA(1, 0, At, B0); PG8_MMA(1, 1, At, B1); PG8_BAR; PG8_SCHED;
        }
        if constexpr (ALIGN_EPI) { if (wr == 0) PG8_BAR; }
        if constexpr (Epi::NPRE > 0) E(acc, cur, wr, wc, fr, fq, epf); else E(acc, cur, wr, wc, fr, fq);
        if (!has_next) break;
#pragma unroll
        for (int a = 0; a < 2; ++a)
#pragma unroll
            for (int b = 0; b < 2; ++b)
#pragma unroll
                for (int m = 0; m < 4; ++m)
#pragma unroll
                    for (int n = 0; n < 2; ++n) acc[a][b][m][n] = (f32x4){0.f, 0.f, 0.f, 0.f};
        cur = nxt; cA = nA; cB = nB; ++ui;
        if constexpr (ALIGN_EPI) { if (wr == 1) PG8_BAR; }
    }
    PG8_WAIT_V(0);
    if constexpr (!ALIGN_EPI) { if (wr == 0) PG8_BAR; }
    PG8_BAR;
#undef PG8_SA
#undef PG8_SB
#undef PG8_STAGE
#undef PG8_LDA
#undef PG8_LDB
#undef PG8_MMA
#undef PG8_WAIT_V
#undef PG8_WAIT_L
#undef PG8_BAR
#undef PG8_SCHED
}
}


#define XB_TMO      128
#define XB_XCNT(j)  (256  + 64 * (j))
#define XB_XSUB(j)  (1280 + 64 * (j))
#define XB_XGEN(j)  (2304 + 64 * (j))
#define XB_TOP      3328
#define XB_TOPGEN   3392
#define XCD_BAR_WORDS 3456
#define XB_SPIN_CAP (1u << 18)
__device__ __forceinline__ unsigned xb_ld(unsigned* p)              { return __hip_atomic_load(p, __ATOMIC_RELAXED, __HIP_MEMORY_SCOPE_AGENT); }
__device__ __forceinline__ unsigned xb_add(unsigned* p, unsigned v) { return __hip_atomic_fetch_add(p, v, __ATOMIC_RELAXED, __HIP_MEMORY_SCOPE_AGENT); }
__device__ __forceinline__ unsigned xb_xcc_id() { return (unsigned)__builtin_amdgcn_s_getreg((3 << 11) | 20) & 0xFu; }
#define XB_SPIN(cond, bar) do { unsigned _sp = 0; while (cond) { __builtin_amdgcn_s_sleep(8); \
    if ((++_sp & 255u) == 0u) { if (xb_ld(&(bar)[XB_TMO])) break; if (_sp > XB_SPIN_CAP) { atomicAdd(&(bar)[XB_TMO], 1u); break; } } } } while (0)
struct XcdBarrier { unsigned* bar; unsigned x; volatile LAS unsigned* st; };
__device__ __forceinline__ XcdBarrier xcd_barrier_post(unsigned* bar, volatile LAS unsigned* st) {
    XcdBarrier b; b.bar = bar; b.x = xb_xcc_id(); b.st = st;
    if (threadIdx.x == 0) (void)xb_add(&bar[XB_XCNT(b.x)], 1u);
    return b;
}
__device__ __forceinline__ void xcd_barrier_complete(unsigned* bar, unsigned x, unsigned& nloc, unsigned& nx, unsigned& uni) {
    const unsigned G = gridDim.x * gridDim.y * gridDim.z;
    unsigned sum, cnt, mine, n32, sp = 0u;
    for (;;) {
        sum = 0u; cnt = 0u; mine = 0u; n32 = 0u;
#pragma unroll
        for (unsigned j = 0; j < 16; ++j) { const unsigned c = xb_ld(&bar[XB_XCNT(j)]); sum += c; cnt += (c > 0u) ? 1u : 0u; n32 += (c == 32u && j < 8u) ? 1u : 0u; mine = (j == x) ? c : mine; }
        if (sum == G) break;
        __builtin_amdgcn_s_sleep(1);
        if ((++sp & 255u) == 0u) { if (xb_ld(&bar[XB_TMO])) break; if (sp > XB_SPIN_CAP) { atomicAdd(&bar[XB_TMO], 1u); break; } }
    }
    nloc = mine > 0u ? mine : 1u; nx = cnt > 0u ? cnt : 1u; uni = (cnt == 8u && n32 == 8u) ? 1u : 0u;
}
__device__ __forceinline__ void xcd_barrier(const XcdBarrier& b) {
    asm volatile("s_waitcnt vmcnt(0)" ::: "memory");
    __syncthreads();
    if (threadIdx.x == 0) {
        unsigned* bar = b.bar;
        __builtin_amdgcn_s_waitcnt(0);
        unsigned nloc = b.st[0], nx = b.st[1];
        if (nloc == 0u) { unsigned uni; xcd_barrier_complete(bar, b.x, nloc, nx, uni); b.st[0] = nloc; b.st[1] = nx; b.st[3] = uni; }
        const unsigned old = xb_add(&bar[XB_XSUB(b.x)], 1u);
        const unsigned gen = old / nloc;
        b.st[2] = old - gen * nloc;
        if (old + 1u == (gen + 1u) * nloc) {
            __builtin_amdgcn_fence(__ATOMIC_RELEASE, "agent");
            asm volatile("s_waitcnt vmcnt(0)" ::: "memory");
            const unsigned og = xb_add(&bar[XB_TOP], 1u);
            const unsigned tg = og / nx;
            if (og + 1u == (tg + 1u) * nx) xb_add(&bar[XB_TOPGEN], 1u);
            else XB_SPIN(xb_ld(&bar[XB_TOPGEN]) == tg, bar);
            __builtin_amdgcn_fence(__ATOMIC_ACQUIRE, "agent");
            xb_add(&bar[XB_XGEN(b.x)], 1u);
            asm volatile("s_waitcnt vmcnt(0)" ::: "memory");
        } else {
            XB_SPIN(xb_ld(&bar[XB_XGEN(b.x)]) == gen, bar);
            __builtin_amdgcn_fence(__ATOMIC_ACQUIRE, "agent");
            asm volatile("s_waitcnt vmcnt(0)" ::: "memory");
        }
    }
    __syncthreads();
}

struct Args { const void* in[25]; float* out; unsigned char* ws; int lo, hi, att_lo, att_hi; };

__device__ __forceinline__ void p0_transpose_item(const float* W, int K, int N, bf16_t* WT, int mode, const float* kscale, LAS unsigned* scr, int item, int lane, int kslice = 0) {
    const int nblk = N / 64, kb = item / nblk, nb = item % nblk, k0 = 64 * kb, n0 = 64 * nb;
    const int lr = lane >> 4, lc = (lane & 15) * 4;
    f32x4 va[8], vb[8];
#pragma unroll
    for (int i = 0; i < 8; ++i) { const int kp = lr + 4 * i; const float* p = W + (size_t)(k0 + 2 * kp) * N + n0 + lc; va[i] = __builtin_nontemporal_load((const f32x4*)p); vb[i] = __builtin_nontemporal_load((const f32x4*)(p + N)); }
#pragma unroll
    for (int i = 0; i < 8; ++i) { const int kp = lr + 4 * i;
        if (kscale) { const float s0 = kscale[k0 + 2 * kp], s1 = kscale[k0 + 2 * kp + 1]; va[i] = va[i] * s0; vb[i] = vb[i] * s1; }
        LAS unsigned* d = scr + kp * 65 + lc;
        d[0] = cvtpk(va[i].x, vb[i].x); d[1] = cvtpk(va[i].y, vb[i].y); d[2] = cvtpk(va[i].z, vb[i].z); d[3] = cvtpk(va[i].w, vb[i].w); }
    asm volatile("s_waitcnt lgkmcnt(0)" ::: "memory");
    const int c = lane & 7;
    const bool special = (mode == 3) && ((n0 >> 8) == 4 || (n0 >> 8) == 9);
    const int r0 = (mode == 0 || mode == 3) ? n0 : ((n0 >> 7) * 256 + (n0 & 127) + (mode == 2 ? 128 : 0));
#pragma unroll
    for (int j = 0; j < 8; ++j) { const int n = (lane >> 3) + 8 * j; const LAS unsigned* sp = scr + (4 * c) * 65 + n;
        u32x4 o; o.x = sp[0]; o.y = sp[65]; o.z = sp[130]; o.w = sp[195];
        const int row = special ? ((n0 & ~255) + 128 * (n >> 5) + 32 * ((n0 >> 6) & 3) + (n & 31)) : (r0 + n);
        if (kslice) *(u32x4*)(WT + (size_t)(k0 / kslice) * N * kslice + (size_t)row * kslice + (k0 % kslice) + 8 * c) = o;
        else *(u32x4*)(WT + (size_t)row * K + k0 + 8 * c) = o; }
    asm volatile("s_waitcnt lgkmcnt(0)" ::: "memory");
}
__device__ __forceinline__ void rms_row2_to_bf16(const float* xrow0, const float* xrow1, const float* g, bf16_t* orow0, bf16_t* orow1, int lane, float* rms0 = nullptr) {
    const f32x4* xa = (const f32x4*)xrow0 + lane; const f32x4* xb = (const f32x4*)xrow1 + lane; const f32x4* gr = (const f32x4*)g + lane;
    f32x4 va[8], vb[8]; float sa = 0.f, sb = 0.f;
#pragma unroll
    for (int j = 0; j < 8; ++j) { va[j] = __builtin_nontemporal_load(xa + 64 * j); vb[j] = __builtin_nontemporal_load(xb + 64 * j); }
#pragma unroll
    for (int j = 0; j < 8; ++j) { sa += (va[j].x * va[j].x + va[j].y * va[j].y) + (va[j].z * va[j].z + va[j].w * va[j].w); sb += (vb[j].x * vb[j].x + vb[j].y * vb[j].y) + (vb[j].z * vb[j].z + vb[j].w * vb[j].w); }
    const float qa = sqrtf(group_sum<64>(sa) * (1.0f / DM) + EPS), qb = sqrtf(group_sum<64>(sb) * (1.0f / DM) + EPS);
    const float ra = 1.0f / qa, rb = 1.0f / qb;
    if (rms0 && lane == 0) { rms0[0] = qa; rms0[1] = qb; }
    u32x2* oa = (u32x2*)orow0 + lane; u32x2* ob = (u32x2*)orow1 + lane;
#pragma unroll
    for (int j = 0; j < 8; ++j) { const f32x4 gg = gr[64 * j];
        u32x2 w; w.x = cvtpk(va[j].x * ra * gg.x, va[j].y * ra * gg.y); w.y = cvtpk(va[j].z * ra * gg.z, va[j].w * ra * gg.w); oa[64 * j] = w;
        u32x2 w2; w2.x = cvtpk(vb[j].x * rb * gg.x, vb[j].y * rb * gg.y); w2.y = cvtpk(vb[j].z * rb * gg.z, vb[j].w * rb * gg.w); ob[64 * j] = w2; }
}

constexpr int N_MLA_UNITS = 256, N_MEM_UNITS = 64, N_SWA_UNITS = 256, N_ATT_UNITS = N_MLA_UNITS + N_MEM_UNITS + N_SWA_UNITS;
constexpr int CV_OUT = (DM / 64) * (DM / 64), CV_G = (DM / 64) * (DFF / 64), CV_DN = (DFF / 64) * (DM / 64), CV_ITEMS = CV_OUT + 2 * CV_G + CV_DN, N_CONV_UNITS = CV_ITEMS / 8;
static_assert(CV_ITEMS % 8 == 0, "conversion items per unit");
constexpr int N_QUEUE_UNITS = N_ATT_UNITS + N_CONV_UNITS;
__device__ __forceinline__ int crow(int r, int hi) { return (r & 3) + 8 * (r >> 2) + 4 * hi; }


template <int S0, int NSEG> __device__ __forceinline__ float qseg_rstd(const bf16x8* qf, float qscale) {
    float ss = 0.f;
#pragma unroll
    for (int s = 0; s < NSEG; ++s) { float f[8]; unpack8(__builtin_bit_cast(u32x4, qf[S0 + s]), f);
#pragma unroll
        for (int j = 0; j < 8; ++j) ss += f[j] * f[j]; }
    ss += __shfl_xor(ss, 32);
    return 1.0f / sqrtf(ss * (1.0f / (16 * NSEG)) + EPS) * qscale;
}
__device__ __forceinline__ void qfrag_scale(const bf16x8 q, const float* g, float rstd, float (&f)[8]) {
    unpack8(__builtin_bit_cast(u32x4, q), f);
    const f32x4 g0 = *(const f32x4*)g, g1 = *(const f32x4*)(g + 4);
    f[0] *= rstd * g0[0]; f[1] *= rstd * g0[1]; f[2] *= rstd * g0[2]; f[3] *= rstd * g0[3];
    f[4] *= rstd * g1[0]; f[5] *= rstd * g1[1]; f[6] *= rstd * g1[2]; f[7] *= rstd * g1[3];
}
template <int S0, int NSEG> __device__ __forceinline__ void qseg_norm(bf16x8* qf, const float* g, float qscale, int hi) {
    const float rstd = qseg_rstd<S0, NSEG>(qf, qscale);
#pragma unroll
    for (int s = 0; s < NSEG; ++s) { float f[8]; qfrag_scale(qf[S0 + s], g + 16 * s + 8 * hi, rstd, f); qf[S0 + s] = __builtin_bit_cast(bf16x8, pack8(f)); }
}
__device__ __forceinline__ void at_glds16(const void* gsrc, unsigned lds_dst) { unsigned keep;
    asm volatile("s_mov_b32 %0, m0\n\ts_mov_b32 m0, %2\n\ts_nop 0\n\tglobal_load_lds_dwordx4 %1, off\n\ts_mov_b32 m0, %0" : "=&s"(keep) : "v"(gsrc), "s"(lds_dst) : "memory"); }
template <int N> __device__ __forceinline__ void at_wait_vm() { asm volatile("s_waitcnt vmcnt(%0)" :: "n"(N) : "memory"); }
template <int D0, int D1> __device__ __forceinline__ const char* at_ksrc3(const bf16_t* k0, int ld0, const bf16_t* k1, int ld1, int key0, int col0, unsigned ko0, unsigned ko1) {
    if constexpr (D1 == 0) { return (const char*)k0 + ((size_t)key0 * ld0 + col0) * 2 + ko0; }
    else { return (col0 < D0) ? ((const char*)k0 + ((size_t)key0 * ld0 + col0) * 2 + ko0) : ((const char*)k1 + ((size_t)key0 * ld1 + (col0 - D0)) * 2 + ko1); }
}
template <int D0, int D1> __device__ __forceinline__ const char* at_ksrc2(const bf16_t* k0, int ld0, const bf16_t* k1, int ld1, int t, int c, unsigned ko0, unsigned ko1) {
    if constexpr (D1 == 0) { return (const char*)k0 + ((size_t)t * 64 * ld0 + c * 8) * 2 + ko0; }
    else { return (c * 8 < D0) ? ((const char*)k0 + ((size_t)t * 64 * ld0 + c * 8) * 2 + ko0) : ((const char*)k1 + ((size_t)t * 64 * ld1 + (c * 8 - D0)) * 2 + ko1); }
}
template <int D0, int D1> __device__ __forceinline__ const bf16_t* at_ksrc(const bf16_t* k0, int ld0, const bf16_t* k1, int ld1, size_t key, int c) {
    if constexpr (D1 == 0) { return k0 + key * ld0 + c * 8; }
    else { return (c * 8 < D0) ? (k0 + key * ld0 + c * 8) : (k1 + key * ld1 + (c * 8 - D0)); }
}
template <int D0, int D1, int DV, int MODE>
__device__ __forceinline__ void attn_unit(LAS unsigned char* lds, const bf16_t* qw, int q_ld, const bf16_t* k0, int ld0, const bf16_t* k1, int ld1, const bf16_t* vp, int ldv,
                                          bf16_t* ow, int o_ld, int t_begin, int t_end,
                                          int qabs  , int wave_tmax  , int wave_tmin,
                                          float slope2, float sink2, int pos_q, const int* posk_g  , bool first_block, const float* qg0, const float* qg1, unsigned* qctl, unsigned& pref) {
    constexpr int DQK = D0 + D1, NKC = DQK / 8, KBYTES = DQK * 128, VBYTES = DV * 128, TBYTES = KBYTES + VBYTES, KI = NKC / 8, VI = DV / 64  , NS = DQK / 16, NDB = DV / 32;
    constexpr int NDMA = KI + VI;
    static_assert(3 * TBYTES + 1024 <= RING_BYTES, "attention LDS");
    int tid_ = threadIdx.x; asm volatile("" : "+v"(tid_));
    asm volatile("" : "+s"(qg0), "+s"(qg1));
    asm volatile("" : "+s"(t_begin), "+s"(t_end));
    const int tid = tid_, lane = tid & 63, wid = __builtin_amdgcn_readfirstlane(tid >> 6), r32 = lane & 31, hi = lane >> 5;
    LAS float* poskf = (LAS float*)(lds + 3 * TBYTES); const float pos_qf = (float)pos_q;
    const int voff = ((4 * hi + ((lane & 15) >> 2)) * 64) + (((lane >> 4) & 1) * 32) + ((lane & 3) * 8);
    const unsigned lds0 = (unsigned)(size_t)lds;
    const unsigned kr_ = (unsigned)(lane >> 3), kc_ = ((unsigned)(lane & 7) ^ kr_ ^ (unsigned)((wid >> 1) & 1));
    const unsigned ko0 = kr_ * (unsigned)ld0 * 2u + kc_ * 16u, ko1 = kr_ * (unsigned)ld1 * 2u + kc_ * 16u, vo = ((unsigned)(lane >> 2) * (unsigned)ldv + (unsigned)(lane & 3) * 8u) * 2u;
    unsigned kro[4];
#pragma unroll
    for (int j = 0; j < 4; ++j) kro[j] = (unsigned)((r32 >> 3) * 1024 + (r32 & 7) * 128) + (((unsigned)(2 * j + hi) ^ (unsigned)(r32 & 7) ^ (unsigned)((r32 >> 4) & 1)) * 16u);
#define AT_DMA(t, b) do { \
        _Pragma("unroll") for (int i = 0; i < KI; ++i) {   \
            const char* src = at_ksrc3<D0, D1>(k0, ld0, k1, ld1, (t) * 64 + 8 * wid, i * 64, ko0, ko1); \
            at_glds16(src, (unsigned)__builtin_amdgcn_readfirstlane((int)(lds0 + (unsigned)((b) * TBYTES + (i * 8 + wid) * 1024)))); } \
        _Pragma("unroll") for (int i = 0; i < VI; ++i) { const int p = wid + 8 * i, dblk = p >> 2, ks = p & 3; \
            const char* src = (const char*)vp + (((size_t)(t) * 64 + ks * 16) * ldv + dblk * 32) * 2 + vo; \
            at_glds16(src, (unsigned)__builtin_amdgcn_readfirstlane((int)(lds0 + (unsigned)((b) * TBYTES + KBYTES + p * 1024)))); } } while (0)
#define AT_BAR() do { asm volatile("" ::: "memory"); __builtin_amdgcn_s_barrier(); asm volatile("" ::: "memory"); } while (0)
    const int nt = t_end - t_begin;
    AT_DMA(t_begin, 0);
    if (nt > 1) AT_DMA(t_begin + 1, 1);
    if constexpr (MODE == 2) { if (tid < 256) poskf[tid] = (first_block && tid < 128) ? 0.f : (float)posk_g[tid]; }
    bf16x8 qf[NS];
#pragma unroll
    for (int s = 0; s < NS; ++s) qf[s] = *(const bf16x8*)(qw + (size_t)r32 * q_ld + 16 * s + 8 * hi);
    if constexpr (MODE == 0) qseg_norm<0, 8>(qf, qg0, QS_MEM, hi);
    if constexpr (MODE == 2) qseg_norm<0, 4>(qf, qg0, QS_SWA, hi);
    if constexpr (MODE == 1) {
        qseg_norm<0, 8>(qf, qg0, QS_MLA, hi);
        const float rstd = qseg_rstd<8, 4>(qf, QS_MLA);
#pragma unroll
        for (int sp = 0; sp < 2; ++sp) { float fa[8], fb[8]; qfrag_scale(qf[8 + sp], qg1 + 16 * sp + 8 * hi, rstd, fa); qfrag_scale(qf[10 + sp], qg1 + 16 * (sp + 2) + 8 * hi, rstd, fb);
#pragma unroll
            for (int j = 0; j < 8; ++j) { float c_, s_; rope_cs(pos_q, 16 * sp + 8 * hi + j, c_, s_); const float x1 = fa[j], x2 = fb[j]; fa[j] = x1 * c_ - x2 * s_; fb[j] = x1 * s_ + x2 * c_; }
            qf[8 + sp] = __builtin_bit_cast(bf16x8, pack8(fa)); qf[10 + sp] = __builtin_bit_cast(bf16x8, pack8(fb)); }
    }
    f32x16 o[NDB];
#pragma unroll
    for (int d = 0; d < NDB; ++d)
#pragma unroll
        for (int r = 0; r < 16; ++r) o[d][r] = 0.f;
    float m_run = (MODE == 2) ? sink2 : -1e30f, l_run = (MODE == 2 && hi == 0) ? 1.f : 0.f;
    if (nt > 1) at_wait_vm<NDMA>(); else at_wait_vm<0>();
    asm volatile("s_waitcnt lgkmcnt(0)" ::: "memory");
    AT_BAR();
    constexpr int NG = NS / 2;
#define AT_KRD(dst, g) do { _Pragma("unroll") for (int s4 = 0; s4 < 2; ++s4) { const int s_ = (g) * 2 + s4; dst[s4][0] = *(const LAS bf16x8*)(kb + kro[s_ & 3] + (s_ >> 2) * 8192); dst[s4][1] = *(const LAS bf16x8*)(kb + kro[s_ & 3] + (s_ >> 2) * 8192 + 4096); } } while (0)
#define AT_KMM(src, g) do { _Pragma("unroll") for (int s4 = 0; s4 < 2; ++s4) { p0 = __builtin_amdgcn_mfma_f32_32x32x16_bf16(src[s4][0], qf[(g) * 2 + s4], p0, 0, 0, 0); p1 = __builtin_amdgcn_mfma_f32_32x32x16_bf16(src[s4][1], qf[(g) * 2 + s4], p1, 0, 0, 0); } } while (0)
#define AT_VRD(dst, d) do { _Pragma("unroll") for (int ks = 0; ks < 4; ++ks) { \
        dst[ks][0] = __builtin_bit_cast(s16x4, __builtin_amdgcn_ds_read_tr16_b64_v4i16((LAS s16x4*)(vb + ((d) * 4 + ks) * 1024))); \
        dst[ks][1] = __builtin_bit_cast(s16x4, __builtin_amdgcn_ds_read_tr16_b64_v4i16((LAS s16x4*)(vb + ((d) * 4 + ks) * 1024 + 512))); } } while (0)
#define AT_VMM(src, d) do { } while (0)
#define AT_VMM2(src, d) do { _Pragma("unroll") for (int ks = 0; ks < 4; ++ks) { \
        const bf16x8 vf = (bf16x8){src[ks][0][0], src[ks][0][1], src[ks][0][2], src[ks][0][3], src[ks][1][0], src[ks][1][1], src[ks][1][2], src[ks][1][3]}; \
        o[d] = __builtin_amdgcn_mfma_f32_32x32x16_bf16(vf, __builtin_bit_cast(bf16x8, pw[ks]), o[d], 0, 0, 0); } } while (0)
#define AT_STEP(B, B2) do { \
        const int t = t_begin + jt; \
        const bool active = (t >= wave_tmin && t <= wave_tmax), more = (jt + 2 < nt); \
        if (more) AT_DMA(t + 2, (B2)); \
        if (active) { \
            const LAS unsigned char* kb = lds + (B) * TBYTES; \
            const LAS unsigned char* vb = lds + (B) * TBYTES + KBYTES + voff; \
            f32x16 p0, p1; \
        _Pragma("unroll") \
            for (int r = 0; r < 16; ++r) { p0[r] = 0.f; p1[r] = 0.f; } \
            { bf16x8 kf[2][2][2]; \
              AT_KRD(kf[0], 0); \
        _Pragma("unroll") \
              for (int g = 0; g < NG; ++g) { \
                  if (g + 1 < NG) AT_KRD(kf[(g + 1) & 1], g + 1); \
                  __builtin_amdgcn_sched_barrier(0); AT_KMM(kf[g & 1], g); __builtin_amdgcn_sched_barrier(0); } } \
            s16x4 va[4][2]; AT_VRD(va, 0); __builtin_amdgcn_sched_barrier(0); \
            if (MODE == 1) { \
                if (t * 64 + 63 > qabs - r32) { \
        _Pragma("unroll") \
                    for (int r = 0; r < 16; ++r) { const int key = t * 64 + crow(r, hi); if (key > qabs) p0[r] = -1e30f; if (key + 32 > qabs) p1[r] = -1e30f; } \
                } \
            } \
            float mx = p0[0]; \
        _Pragma("unroll") \
            for (int r = 1; r < 16; ++r) mx = fmaxf(mx, p0[r]); \
        _Pragma("unroll") \
            for (int r = 0; r < 16; ++r) mx = fmaxf(mx, p1[r]); \
            mx = fmaxf(mx, __shfl_xor(mx, 32)); \
              \
            const float mn = (mx > m_run + 8.0f) ? mx : m_run, alpha = __builtin_amdgcn_exp2f(m_run - mn); m_run = mn; \
            float rs = 0.f; \
        _Pragma("unroll") \
            for (int r = 0; r < 16; ++r) { p0[r] = __builtin_amdgcn_exp2f(p0[r] - mn); p1[r] = __builtin_amdgcn_exp2f(p1[r] - mn); rs += p0[r] + p1[r]; } \
            l_run = l_run * alpha + rs; \
            if (__builtin_amdgcn_ballot_w64(alpha != 1.0f) != 0ull) { \
        _Pragma("unroll") \
                for (int d = 0; d < NDB; ++d) \
        _Pragma("unroll") \
                    for (int r = 0; r < 16; ++r) o[d][r] *= alpha; \
            } \
            u32x4 pw[4]; \
        _Pragma("unroll") \
            for (int e = 0; e < 4; ++e) { pw[0][e] = cvtpk(p0[2 * e], p0[2 * e + 1]); pw[1][e] = cvtpk(p0[8 + 2 * e], p0[8 + 2 * e + 1]); pw[2][e] = cvtpk(p1[2 * e], p1[2 * e + 1]); pw[3][e] = cvtpk(p1[8 + 2 * e], p1[8 + 2 * e + 1]); } \
            { if constexpr (NDB > 1) { s16x4 vc[4][2]; AT_VRD(vc, 1); __builtin_amdgcn_sched_barrier(0); AT_VMM2(va, 0); __builtin_amdgcn_sched_barrier(0); \
                if constexpr (NDB > 2) { AT_VRD(va, 2); __builtin_amdgcn_sched_barrier(0); AT_VMM2(vc, 1); __builtin_amdgcn_sched_barrier(0); \
                  AT_VRD(vc, 3); __builtin_amdgcn_sched_barrier(0); AT_VMM2(va, 2); __builtin_amdgcn_sched_barrier(0); AT_VMM2(vc, 3); } \
                else { AT_VMM2(vc, 1); } } \
              else { AT_VMM2(va, 0); } } \
        } \
        if (more) at_wait_vm<NDMA>(); else at_wait_vm<0>(); \
        AT_BAR(); \
    } while (0)
    if (wid >= 4) __builtin_amdgcn_s_setprio(1);
    for (int jt = 0; jt < nt; ) {
        AT_STEP(0, 2); if (++jt >= nt) break;
        AT_STEP(1, 0); if (++jt >= nt) break;
        AT_STEP(2, 1); ++jt;
    }
#undef AT_STEP
    __builtin_amdgcn_s_setprio(0);
    if (tid == 0) pref = atomicAdd(qctl, 1u);
#undef AT_KRD
#undef AT_KMM
#undef AT_VRD
#undef AT_VMM
#undef AT_VMM2
#undef AT_DMA
#undef AT_BAR
    const float lt = l_run + __shfl_xor(l_run, 32);
    const float inv = __builtin_amdgcn_rcpf(lt);
    bf16_t* orow = ow + (size_t)r32 * o_ld;
#pragma unroll
    for (int d = 0; d < NDB; ++d)
#pragma unroll
        for (int j2 = 0; j2 < 2; ++j2) {
            u32x2 P0, P1;
            P0.x = cvtpk(o[d][8 * j2] * inv, o[d][8 * j2 + 1] * inv); P0.y = cvtpk(o[d][8 * j2 + 2] * inv, o[d][8 * j2 + 3] * inv);
            P1.x = cvtpk(o[d][8 * j2 + 4] * inv, o[d][8 * j2 + 5] * inv); P1.y = cvtpk(o[d][8 * j2 + 6] * inv, o[d][8 * j2 + 7] * inv);
            const unsigned sx = hi ? P0.x : P1.x, sy = hi ? P0.y : P1.y;
            const unsigned rx = (unsigned)__shfl_xor((int)sx, 32), ry = (unsigned)__shfl_xor((int)sy, 32);
            u32x4 w;
            if (hi == 0) { w.x = P0.x; w.y = P0.y; w.z = rx; w.w = ry; } else { w.x = rx; w.y = ry; w.z = P1.x; w.w = P1.y; }
            *(u32x4*)(orow + 32 * d + 16 * j2 + 8 * hi) = w;
        }
}


__device__ __forceinline__ void swa_unit(LAS unsigned char* lds, const bf16_t* PROJ, bf16_t* Y, const int* positions, const float* qg, const float* sinks, int b, int n, int kvh, unsigned* qctl, unsigned& pref) {
    int tid_ = threadIdx.x; asm volatile("" : "+v"(tid_));
    asm volatile("" : "+s"(qg), "+s"(sinks));
    const int tid = tid_, lane = tid & 63, wid = __builtin_amdgcn_readfirstlane(tid >> 6), r32 = lane & 31, hi = lane >> 5, w4 = wid & 3;
    constexpr int SLOT = 16384, KB_ = 8192;
    LAS float* poskf = (LAS float*)(lds + 4 * SLOT);
    const int t_begin = (n == 0) ? 2 : 0;
    const long key0 = (long)b * SEQ + 128 * (n - 1);
    const bf16_t* Kg = PROJ + key0 * INP + C_KA + kvh * 64; const bf16_t* Vg = PROJ + key0 * INP + C_VA + kvh * 64;
    const unsigned lds0 = (unsigned)(size_t)lds;
    { const unsigned kr_ = (unsigned)(lane >> 3), kc_ = ((unsigned)(lane & 7) ^ kr_ ^ (unsigned)((wid >> 1) & 1));
      const unsigned ko = kr_ * (unsigned)INP * 2u + kc_ * 16u, vo = ((unsigned)(lane >> 2) * (unsigned)INP + (unsigned)(lane & 3) * 8u) * 2u;
      for (int t = t_begin; t < 4; ++t) {
          at_glds16((const char*)Kg + ((size_t)(t * 64 + 8 * wid) * INP) * 2 + ko, (unsigned)__builtin_amdgcn_readfirstlane((int)(lds0 + (unsigned)(t * SLOT + wid * 1024))));
          at_glds16((const char*)Vg + (((size_t)(t * 64 + (wid & 3) * 16)) * INP + (wid >> 2) * 32) * 2 + vo, (unsigned)__builtin_amdgcn_readfirstlane((int)(lds0 + (unsigned)(t * SLOT + KB_ + wid * 1024)))); }
      if (tid < 256) poskf[tid] = (n == 0 && tid < 128) ? 0.f : (float)positions[key0 + tid]; }
    unsigned kro[4];
#pragma unroll
    for (int j = 0; j < 4; ++j) kro[j] = (unsigned)((r32 >> 3) * 1024 + (r32 & 7) * 128) + (((unsigned)(2 * j + hi) ^ (unsigned)(r32 & 7) ^ (unsigned)((r32 >> 4) & 1)) * 16u);
    const int voff = ((4 * hi + ((lane & 15) >> 2)) * 64) + (((lane >> 4) & 1) * 32) + ((lane & 3) * 8);
    const size_t tok0 = (size_t)b * SEQ + 128 * n + 32 * w4;
    const float pos_qf = (float)positions[tok0 + r32];
    const int qloc = 32 * w4 + r32;
    const int tlo = (w4 < 2) ? t_begin : (t_begin > 1 ? t_begin : 1), thi = (w4 < 2) ? 2 : 3;
    float sk4[4];
#pragma unroll
    for (int i = 0; i < 4; ++i) sk4[i] = sinks[kvh * 8 + i * 2 + (wid >> 2)];
    bf16x8 qn[4];
    { const bf16_t* qw = PROJ + tok0 * INP + C_QA + (kvh * 8 + (wid >> 2)) * 64;
#pragma unroll
      for (int s = 0; s < 4; ++s) qn[s] = *(const bf16x8*)(qw + (size_t)r32 * INP + 16 * s + 8 * hi); }
#pragma unroll 1
    for (int hp = 0; hp < 4; ++hp) {
        if (hp == 3 && tid == 0) pref = atomicAdd(qctl, 1u);
        const int head = kvh * 8 + hp * 2 + (wid >> 2);
        bf16x8 qf[4];
#pragma unroll
        for (int s = 0; s < 4; ++s) qf[s] = qn[s];
        if (hp < 3) { const bf16_t* qw = PROJ + tok0 * INP + C_QA + (head + 2) * 64;
#pragma unroll
            for (int s = 0; s < 4; ++s) qn[s] = *(const bf16x8*)(qw + (size_t)r32 * INP + 16 * s + 8 * hi); }
        { const float* qg2 = qg; asm volatile("" : "+s"(qg2)); qseg_norm<0, 4>(qf, qg2, QS_SWA, hi); }
        const float slope2 = __builtin_amdgcn_exp2f(-0.5f * (float)(head + 1)) * LOG2E, sink2 = ((hp == 0) ? sk4[0] : (hp == 1) ? sk4[1] : (hp == 2) ? sk4[2] : sk4[3]) * LOG2E;
        if (hp == 0) { asm volatile("s_waitcnt vmcnt(0) lgkmcnt(0)" ::: "memory"); __builtin_amdgcn_s_barrier(); asm volatile("" ::: "memory"); }
        f32x16 o[2];
#pragma unroll
        for (int d = 0; d < 2; ++d)
#pragma unroll
            for (int r = 0; r < 16; ++r) o[d][r] = 0.f;
        float m_run = sink2, l_run = (hi == 0) ? 1.f : 0.f;
#pragma unroll 1
        for (int t = tlo; t <= thi; ++t) {
            const LAS unsigned char* kb = lds + t * SLOT;
            const bool n0 = (2 * t >= w4) && (2 * t <= w4 + 4), n1 = (2 * t + 1 >= w4) && (2 * t + 1 <= w4 + 4);
            f32x16 p0, p1;
#pragma unroll
            for (int r = 0; r < 16; ++r) { p0[r] = 0.f; p1[r] = 0.f; }
            bf16x8 ka[4][2];
#pragma unroll
            for (int s4 = 0; s4 < 4; ++s4) { ka[s4][0] = *(const LAS bf16x8*)(kb + kro[s4]); ka[s4][1] = *(const LAS bf16x8*)(kb + kro[s4] + 4096); }
            if (n0) {
#pragma unroll
                for (int s4 = 0; s4 < 4; ++s4) p0 = __builtin_amdgcn_mfma_f32_32x32x16_bf16(ka[s4][0], qf[s4], p0, 0, 0, 0); }
            if (n1) {
#pragma unroll
                for (int s4 = 0; s4 < 4; ++s4) p1 = __builtin_amdgcn_mfma_f32_32x32x16_bf16(ka[s4][1], qf[s4], p1, 0, 0, 0); }
            const LAS unsigned char* vb = lds + t * SLOT + KB_ + voff;
            s16x4 va[2][4][2];
#pragma unroll
            for (int d = 0; d < 2; ++d)
#pragma unroll
                for (int ks = 0; ks < 4; ++ks) {
                    va[d][ks][0] = __builtin_bit_cast(s16x4, __builtin_amdgcn_ds_read_tr16_b64_v4i16((LAS s16x4*)(vb + (d * 4 + ks) * 1024)));
                    va[d][ks][1] = __builtin_bit_cast(s16x4, __builtin_amdgcn_ds_read_tr16_b64_v4i16((LAS s16x4*)(vb + (d * 4 + ks) * 1024 + 512))); }
            const int qk0 = 128 + qloc - t * 64 - 4 * hi;
            float mx = -1e30f;
            if (n0) {
#pragma unroll
                for (int r = 0; r < 16; ++r) {
                    const int kl = (r & 3) + 8 * (r >> 2), ki0 = t * 64 + 4 * hi + kl;
                    const float b0 = fmaf(-slope2, fabsf(pos_qf - poskf[ki0]), p0[r]);
                    p0[r] = ((unsigned)(qk0 - kl) < 128u) ? b0 : -1e30f;
                    mx = fmaxf(mx, p0[r]);
                } }
            if (n1) {
#pragma unroll
                for (int r = 0; r < 16; ++r) {
                    const int kl = (r & 3) + 8 * (r >> 2), ki0 = t * 64 + 4 * hi + kl;
                    const float b1 = fmaf(-slope2, fabsf(pos_qf - poskf[ki0 + 32]), p1[r]);
                    p1[r] = ((unsigned)(qk0 - kl - 32) < 128u) ? b1 : -1e30f;
                    mx = fmaxf(mx, p1[r]);
                } }
            mx = fmaxf(mx, __shfl_xor(mx, 32));
            const float mn = (mx > m_run + 8.0f) ? mx : m_run, alpha = __builtin_amdgcn_exp2f(m_run - mn); m_run = mn;
            float rs = 0.f;
            if (n0) {
#pragma unroll
                for (int r = 0; r < 16; ++r) { p0[r] = __builtin_amdgcn_exp2f(p0[r] - mn); rs += p0[r]; } }
            if (n1) {
#pragma unroll
                for (int r = 0; r < 16; ++r) { p1[r] = __builtin_amdgcn_exp2f(p1[r] - mn); rs += p1[r]; } }
            l_run = l_run * alpha + rs;
            if (__builtin_amdgcn_ballot_w64(alpha != 1.0f) != 0ull) {
#pragma unroll
                for (int d = 0; d < 2; ++d)
#pragma unroll
                    for (int r = 0; r < 16; ++r) o[d][r] *= alpha;
            }
            if (n0) {
                u32x4 pw[2];
#pragma unroll
                for (int e = 0; e < 4; ++e) { pw[0][e] = cvtpk(p0[2 * e], p0[2 * e + 1]); pw[1][e] = cvtpk(p0[8 + 2 * e], p0[8 + 2 * e + 1]); }
#pragma unroll
                for (int d = 0; d < 2; ++d)
#pragma unroll
                    for (int ks = 0; ks < 2; ++ks) {
                        const bf16x8 vf = (bf16x8){va[d][ks][0][0], va[d][ks][0][1], va[d][ks][0][2], va[d][ks][0][3], va[d][ks][1][0], va[d][ks][1][1], va[d][ks][1][2], va[d][ks][1][3]};
                        o[d] = __builtin_amdgcn_mfma_f32_32x32x16_bf16(vf, __builtin_bit_cast(bf16x8, pw[ks]), o[d], 0, 0, 0); } }
            if (n1) {
                u32x4 pw[2];
#pragma unroll
                for (int e = 0; e < 4; ++e) { pw[0][e] = cvtpk(p1[2 * e], p1[2 * e + 1]); pw[1][e] = cvtpk(p1[8 + 2 * e], p1[8 + 2 * e + 1]); }
#pragma unroll
                for (int d = 0; d < 2; ++d)
#pragma unroll
                    for (int ks = 2; ks < 4; ++ks) {
                        const bf16x8 vf = (bf16x8){va[d][ks][0][0], va[d][ks][0][1], va[d][ks][0][2], va[d][ks][0][3], va[d][ks][1][0], va[d][ks][1][1], va[d][ks][1][2], va[d][ks][1][3]};
                        o[d] = __builtin_amdgcn_mfma_f32_32x32x16_bf16(vf, __builtin_bit_cast(bf16x8, pw[ks - 2]), o[d], 0, 0, 0); } }
        }
        const float lt = l_run + __shfl_xor(l_run, 32);
        const float inv = __builtin_amdgcn_rcpf(lt);
        bf16_t* orow = Y + (tok0 + r32) * DM + head * 64;
#pragma unroll
        for (int d = 0; d < 2; ++d)
#pragma unroll
            for (int j2 = 0; j2 < 2; ++j2) {
                u32x2 P0, P1;
                P0.x = cvtpk(o[d][8 * j2] * inv, o[d][8 * j2 + 1] * inv); P0.y = cvtpk(o[d][8 * j2 + 2] * inv, o[d][8 * j2 + 3] * inv);
                P1.x = cvtpk(o[d][8 * j2 + 4] * inv, o[d][8 * j2 + 5] * inv); P1.y = cvtpk(o[d][8 * j2 + 6] * inv, o[d][8 * j2 + 7] * inv);
                const unsigned sx = hi ? P0.x : P1.x, sy = hi ? P0.y : P1.y;
                const unsigned rx = (unsigned)__shfl_xor((int)sx, 32), ry = (unsigned)__shfl_xor((int)sy, 32);
                u32x4 w;
                if (hi == 0) { w.x = P0.x; w.y = P0.y; w.z = rx; w.w = ry; } else { w.x = rx; w.y = ry; w.z = P1.x; w.w = P1.y; }
                *(u32x4*)(orow + 32 * d + 16 * j2 + 8 * hi) = w;
            }
    }
    asm volatile("s_waitcnt lgkmcnt(0)" ::: "memory"); __builtin_amdgcn_s_barrier(); asm volatile("" ::: "memory");
}


__device__ __forceinline__ void kvm_finalize_bh(const float* KVMP, bf16_t* KVM, const float* gk, int b, int h, int tid_) {
    int tid = tid_; asm volatile("" : "+v"(tid));
    const int lane = tid & 63, w = tid >> 6, sub = lane >> 5, kv = (lane >> 4) & 1, l16 = lane & 15;
    const int col = kv * 512 + h * 128 + 8 * l16;
    float gg[8];
#pragma unroll
    for (int i = 0; i < 8; ++i) gg[i] = gk[8 * l16 + i];
#pragma unroll 1
    for (int bt = 0; bt < 4; ++bt) {
        f32x4 ld[4][4][2];
#pragma unroll
        for (int j = 0; j < 4; ++j) { const int t = b * MEML + w * 32 + (bt * 4 + j) * 2 + sub;
#pragma unroll
            for (int ks = 0; ks < 4; ++ks) { const float* p = KVMP + ((size_t)ks * MMEM + t) * 1024 + col; ld[j][ks][0] = *(const f32x4*)p; ld[j][ks][1] = *(const f32x4*)(p + 4); } }
#pragma unroll
        for (int j = 0; j < 4; ++j) { const int t = b * MEML + w * 32 + (bt * 4 + j) * 2 + sub; float f[8];
#pragma unroll
            for (int i = 0; i < 8; ++i) f[i] = 0.f;
#pragma unroll
            for (int ks = 0; ks < 4; ++ks) { const f32x4 a = ld[j][ks][0], c = ld[j][ks][1];
                f[0] += a[0]; f[1] += a[1]; f[2] += a[2]; f[3] += a[3]; f[4] += c[0]; f[5] += c[1]; f[6] += c[2]; f[7] += c[3]; }
            float ss = 0.f;
#pragma unroll
            for (int i = 0; i < 8; ++i) ss += f[i] * f[i];
            const float rstd = 1.0f / sqrtf(group_sum<16>(ss) * (1.0f / 128) + EPS);
#pragma unroll
            for (int i = 0; i < 8; ++i) f[i] = kv ? f[i] : f[i] * rstd * gg[i];
            *(u32x4*)(KVM + (size_t)t * 1024 + col) = pack8(f); }
    }
    asm volatile("s_waitcnt vmcnt(0)" ::: "memory");
    __syncthreads();
}

__device__ __forceinline__ void mem_unit(LAS unsigned char* lds, const bf16_t* PROJ, const bf16_t* KVM, bf16_t* Y, const float* qg, int b, int h, int qq, unsigned* qctl, unsigned& pref) {
    int tid_ = threadIdx.x; asm volatile("" : "+v"(tid_));
    asm volatile("" : "+s"(qg));
    const int tid = tid_, lane = tid & 63, wid = __builtin_amdgcn_readfirstlane(tid >> 6), r32 = lane & 31, hi = lane >> 5;
    constexpr int SLOT = 32768, KB_ = 16384;
    const bf16_t* Kg = KVM + (size_t)b * MEML * 1024 + h * 128; const bf16_t* Vg = Kg + 512;
    const unsigned lds0 = (unsigned)(size_t)lds;
    { const unsigned kr_ = (unsigned)(lane >> 3), kc_ = ((unsigned)(lane & 7) ^ kr_ ^ (unsigned)((wid >> 1) & 1));
      const unsigned ko = kr_ * 1024u * 2u + kc_ * 16u, vo = ((unsigned)(lane >> 2) * 1024u + (unsigned)(lane & 3) * 8u) * 2u;
      for (int t = 0; t < 4; ++t) {
#pragma unroll
          for (int i = 0; i < 2; ++i) {
              at_glds16((const char*)Kg + ((size_t)(t * 64 + 8 * wid) * 1024 + i * 64) * 2 + ko, (unsigned)__builtin_amdgcn_readfirstlane((int)(lds0 + (unsigned)(t * SLOT + (i * 8 + wid) * 1024))));
              const int p = wid + 8 * i, dblk = p >> 2, ks = p & 3;
              at_glds16((const char*)Vg + (((size_t)(t * 64 + ks * 16)) * 1024 + dblk * 32) * 2 + vo, (unsigned)__builtin_amdgcn_readfirstlane((int)(lds0 + (unsigned)(t * SLOT + KB_ + p * 1024)))); } } }
    unsigned kro[4];
#pragma unroll
    for (int j = 0; j < 4; ++j) kro[j] = (unsigned)((r32 >> 3) * 1024 + (r32 & 7) * 128) + (((unsigned)(2 * j + hi) ^ (unsigned)(r32 & 7) ^ (unsigned)((r32 >> 4) & 1)) * 16u);
    const int voff = ((4 * hi + ((lane & 15) >> 2)) * 64) + (((lane >> 4) & 1) * 32) + ((lane & 3) * 8);
    bf16x8 qn[8];
    { const bf16_t* qw = PROJ + ((size_t)b * SEQ + 256 * (4 * qq) + 32 * wid) * INP + C_QM + h * 128;
#pragma unroll
      for (int s = 0; s < 8; ++s) qn[s] = *(const bf16x8*)(qw + (size_t)r32 * INP + 16 * s + 8 * hi); }
#pragma unroll 1
    for (int pass = 0; pass < 4; ++pass) {
        if (pass == 3 && tid == 0) pref = atomicAdd(qctl, 1u);
        const size_t tok0 = (size_t)b * SEQ + 256 * (4 * qq + pass) + 32 * wid;
        bf16x8 qf[8];
#pragma unroll
        for (int s = 0; s < 8; ++s) qf[s] = qn[s];
        if (pass < 3) { const bf16_t* qw = PROJ + (tok0 + 256) * INP + C_QM + h * 128;
#pragma unroll
            for (int s = 0; s < 8; ++s) qn[s] = *(const bf16x8*)(qw + (size_t)r32 * INP + 16 * s + 8 * hi); }
        { const float* qg2 = qg; asm volatile("" : "+s"(qg2)); qseg_norm<0, 8>(qf, qg2, QS_MEM, hi); }
        if (pass == 0) { asm volatile("s_waitcnt vmcnt(0) lgkmcnt(0)" ::: "memory"); __builtin_amdgcn_s_barrier(); asm volatile("" ::: "memory"); }
        f32x16 o[4];
#pragma unroll
        for (int d = 0; d < 4; ++d)
#pragma unroll
            for (int r = 0; r < 16; ++r) o[d][r] = 0.f;
        float m_run = -1e30f, l_run = 0.f;
#pragma unroll 1
        for (int t = 0; t < 4; ++t) {
            const LAS unsigned char* kb = lds + t * SLOT;
            const LAS unsigned char* vb = lds + t * SLOT + KB_ + voff;
            f32x16 p0, p1;
#pragma unroll
            for (int r = 0; r < 16; ++r) { p0[r] = 0.f; p1[r] = 0.f; }
            { bf16x8 kf[2][2][2];
#pragma unroll
              for (int s4 = 0; s4 < 2; ++s4) { kf[0][s4][0] = *(const LAS bf16x8*)(kb + kro[s4]); kf[0][s4][1] = *(const LAS bf16x8*)(kb + kro[s4] + 4096); }
#pragma unroll
              for (int g = 0; g < 4; ++g) {
                  if (g + 1 < 4) {
#pragma unroll
                      for (int s4 = 0; s4 < 2; ++s4) { const int s_ = (g + 1) * 2 + s4; kf[(g + 1) & 1][s4][0] = *(const LAS bf16x8*)(kb + kro[s_ & 3] + (s_ >> 2) * 8192); kf[(g + 1) & 1][s4][1] = *(const LAS bf16x8*)(kb + kro[s_ & 3] + (s_ >> 2) * 8192 + 4096); } }
                  __builtin_amdgcn_sched_barrier(0);
#pragma unroll
                  for (int s4 = 0; s4 < 2; ++s4) { p0 = __builtin_amdgcn_mfma_f32_32x32x16_bf16(kf[g & 1][s4][0], qf[g * 2 + s4], p0, 0, 0, 0); p1 = __builtin_amdgcn_mfma_f32_32x32x16_bf16(kf[g & 1][s4][1], qf[g * 2 + s4], p1, 0, 0, 0); }
                  __builtin_amdgcn_sched_barrier(0); } }
            float mx = p0[0];
#pragma unroll
            for (int r = 1; r < 16; ++r) mx = fmaxf(mx, p0[r]);
#pragma unroll
            for (int r = 0; r < 16; ++r) mx = fmaxf(mx, p1[r]);
            mx = fmaxf(mx, __shfl_xor(mx, 32));
            const float mn = (mx > m_run + 8.0f) ? mx : m_run, alpha = __builtin_amdgcn_exp2f(m_run - mn); m_run = mn;
            float rs = 0.f;
#pragma unroll
            for (int r = 0; r < 16; ++r) { p0[r] = __builtin_amdgcn_exp2f(p0[r] - mn); p1[r] = __builtin_amdgcn_exp2f(p1[r] - mn); rs += p0[r] + p1[r]; }
            l_run = l_run * alpha + rs;
            if (__builtin_amdgcn_ballot_w64(alpha != 1.0f) != 0ull) {
#pragma unroll
                for (int d = 0; d < 4; ++d)
#pragma unroll
                    for (int r = 0; r < 16; ++r) o[d][r] *= alpha;
            }
            u32x4 pw[4];
#pragma unroll
            for (int e = 0; e < 4; ++e) { pw[0][e] = cvtpk(p0[2 * e], p0[2 * e + 1]); pw[1][e] = cvtpk(p0[8 + 2 * e], p0[8 + 2 * e + 1]); pw[2][e] = cvtpk(p1[2 * e], p1[2 * e + 1]); pw[3][e] = cvtpk(p1[8 + 2 * e], p1[8 + 2 * e + 1]); }
#pragma unroll
            for (int d = 0; d < 4; ++d) {
                s16x4 va[4][2];
#pragma unroll
                for (int ks = 0; ks < 4; ++ks) {
                    va[ks][0] = __builtin_bit_cast(s16x4, __builtin_amdgcn_ds_read_tr16_b64_v4i16((LAS s16x4*)(vb + (d * 4 + ks) * 1024)));
                    va[ks][1] = __builtin_bit_cast(s16x4, __builtin_amdgcn_ds_read_tr16_b64_v4i16((LAS s16x4*)(vb + (d * 4 + ks) * 1024 + 512))); }
#pragma unroll
                for (int ks = 0; ks < 4; ++ks) {
                    const bf16x8 vf = (bf16x8){va[ks][0][0], va[ks][0][1], va[ks][0][2], va[ks][0][3], va[ks][1][0], va[ks][1][1], va[ks][1][2], va[ks][1][3]};
                    o[d] = __builtin_amdgcn_mfma_f32_32x32x16_bf16(vf, __builtin_bit_cast(bf16x8, pw[ks]), o[d], 0, 0, 0); }
                __builtin_amdgcn_sched_barrier(0); }
        }
        const float lt = l_run + __shfl_xor(l_run, 32);
        const float inv = __builtin_amdgcn_rcpf(lt);
        bf16_t* orow = Y + (tok0 + r32) * DM + 1536 + h * 128;
#pragma unroll
        for (int d = 0; d < 4; ++d)
#pragma unroll
            for (int j2 = 0; j2 < 2; ++j2) {
                u32x2 P0, P1;
                P0.x = cvtpk(o[d][8 * j2] * inv, o[d][8 * j2 + 1] * inv); P0.y = cvtpk(o[d][8 * j2 + 2] * inv, o[d][8 * j2 + 3] * inv);
                P1.x = cvtpk(o[d][8 * j2 + 4] * inv, o[d][8 * j2 + 5] * inv); P1.y = cvtpk(o[d][8 * j2 + 6] * inv, o[d][8 * j2 + 7] * inv);
                const unsigned sx = hi ? P0.x : P1.x, sy = hi ? P0.y : P1.y;
                const unsigned rx = (unsigned)__shfl_xor((int)sx, 32), ry = (unsigned)__shfl_xor((int)sy, 32);
                u32x4 w;
                if (hi == 0) { w.x = P0.x; w.y = P0.y; w.z = rx; w.w = ry; } else { w.x = rx; w.y = ry; w.z = P1.x; w.w = P1.y; }
                *(u32x4*)(orow + 32 * d + 16 * j2 + 8 * hi) = w;
            }
    }
    asm volatile("s_waitcnt lgkmcnt(0)" ::: "memory"); __builtin_amdgcn_s_barrier(); asm volatile("" ::: "memory");
}

constexpr int NPH = 9;
__global__ void __launch_bounds__(512, 2) fwd_kernel(Args args) {
    extern __shared__ __attribute__((aligned(16))) unsigned char lds_raw[];
    LAS unsigned char* lds = (LAS unsigned char*)lds_raw;
    const int tid = threadIdx.x, lane = tid & 63, wave = __builtin_amdgcn_readfirstlane(tid >> 6);
    const int G = gridDim.x, bx = blockIdx.x;
    const int gw = bx * 8 + wave, NGW = G * 8;
    unsigned char* ws = args.ws;
    const float* x = (const float*)args.in[0]; const float* mem = (const float*)args.in[1]; const int* positions = (const int*)args.in[2];
    const float* attn_norm_g = (const float*)args.in[3]; const float* w_in = (const float*)args.in[4];
    const float* swa_q_norm_g = (const float*)args.in[5]; const float* swa_k_norm_g = (const float*)args.in[6]; const float* swa_sinks = (const float*)args.in[7];
    const float* mla_cq_norm_g = (const float*)args.in[8]; const float* mla_ckv_norm_g = (const float*)args.in[9];
    const float* w_uq = (const float*)args.in[10]; const float* w_ukv = (const float*)args.in[11];
    const float* mla_qn_norm_g = (const float*)args.in[12]; const float* mla_qr_norm_g = (const float*)args.in[13];
    const float* mla_kn_norm_g = (const float*)args.in[14]; const float* mla_kr_norm_g = (const float*)args.in[15];
    const float* mem_norm_g = (const float*)args.in[16]; const float* w_mem_kv = (const float*)args.in[17];
    const float* mem_q_norm_g = (const float*)args.in[18]; const float* mem_k_norm_g = (const float*)args.in[19];
    const float* w_out = (const float*)args.in[20]; const float* ffn_norm_g = (const float*)args.in[21];
    const float* w_gate = (const float*)args.in[22]; const float* w_up = (const float*)args.in[23]; const float* w_down = (const float*)args.in[24];
    float* out = args.out;
    unsigned* ctl = (unsigned*)(ws + WS_CTL); float* ssq = (float*)(ws + WS_SSQ); float* ssq_cq = ssq + MTOK; float* ssq_ckv = ssq + 2 * MTOK; float* xrms = (float*)(ws + WS_XRMS); float* ginv = (float*)(ws + WS_GINV);
    bf16_t* WIN = (bf16_t*)(ws + WS_WIN); bf16_t* WUQKV = (bf16_t*)(ws + WS_WUQKV); bf16_t* WMEM = (bf16_t*)(ws + WS_WMEM); bf16_t* WOUT = (bf16_t*)(ws + WS_WOUT);
    bf16_t* WGU = (bf16_t*)(ws + WS_WGU); bf16_t* WDN = (bf16_t*)(ws + WS_WDN);
    bf16_t* XN = (bf16_t*)(ws + WS_XN); bf16_t* HB = XN; bf16_t* Y = (bf16_t*)(ws + WS_Y); bf16_t* MEMN = (bf16_t*)(ws + WS_MEMN); bf16_t* KVM = (bf16_t*)(ws + WS_KVM);
    float* KVMP = (float*)(ws + WS_KVMP); bf16_t* PROJ = (bf16_t*)(ws + WS_PROJ); bf16_t* QKVB = (bf16_t*)(ws + WS_QKVB); bf16_t* ACT = (bf16_t*)(ws + WS_ACT);
    const int lo = args.lo, hi = args.hi;
    cg::grid_group grid = cg::this_grid();
    volatile LAS unsigned* MISC = (volatile LAS unsigned*)(lds + MISC_OFF);
    if (tid < 64) MISC[tid] = 0u;
    __syncthreads();
    XcdBarrier bar; bar.bar = ctl + CW_BAR; bar.x = 0; bar.st = MISC + 8;
    if (hi - lo > 1) bar = xcd_barrier_post(ctl + CW_BAR, MISC + 8);
    if (hi > 1000) grid.sync();
#define IN(k) (lo <= (k) && (k) < hi)
#define SEAM(k) do { if ((k) + 1 < hi) xcd_barrier(bar); } while (0)

    if (IN(0)) {
        LAS unsigned* scr = (LAS unsigned*)(lds + wave * 16384);
        constexpr int I_IN = (DM / 64) * (INW / 64), I_UQ = (512 / 64) * (768 / 64), I_UKV = (512 / 64) * (1024 / 64), I_MEM = (DM / 64) * (1024 / 64), I_OUT = (DM / 64) * (DM / 64),
                      I_G = (DM / 64) * (DFF / 64), I_DN = (DFF / 64) * (DM / 64);
        constexpr int NITEMS = I_IN + I_UQ + I_UKV + I_MEM;
        for (int it = gw; it < NITEMS; it += NGW) {
            int r = it;
            if (r < I_IN) { p0_transpose_item(w_in, DM, INW, WIN, 3, nullptr, scr, r, lane); continue; } r -= I_IN;
            if (r < I_UQ) { p0_transpose_item(w_uq, 512, 768, WUQKV, 0, mla_cq_norm_g, scr, r, lane); continue; } r -= I_UQ;
            if (r < I_UKV) { p0_transpose_item(w_ukv, 512, 1024, WUQKV + (size_t)768 * 512, 0, mla_ckv_norm_g, scr, r, lane); continue; } r -= I_UKV;
            p0_transpose_item(w_mem_kv, DM, 1024, WMEM, 0, nullptr, scr, r, lane, 512);
        }
        for (int i = bx * 512 + tid; i < DM; i += G * 512) ginv[i] = 1.0f / attn_norm_g[i];
        { u32x4* z = (u32x4*)(WIN + (size_t)INW * DM); const int nz = (INP - INW) * DM * 2 / 16; for (int i = bx * 512 + tid; i < nz; i += G * 512) z[i] = (u32x4){0u, 0u, 0u, 0u}; }
        for (int m = 2 * gw; m < MTOK; m += 2 * NGW) rms_row2_to_bf16(x + (size_t)m * DM, x + (size_t)(m + 1) * DM, attn_norm_g, XN + (size_t)m * DM, XN + (size_t)(m + 1) * DM, lane, xrms + m);
        for (int m = 2 * gw; m < MMEM; m += 2 * NGW) rms_row2_to_bf16(mem + (size_t)m * DM, mem + (size_t)(m + 1) * DM, mem_norm_g, MEMN + (size_t)m * INP, MEMN + (size_t)(m + 1) * INP, lane);
        SEAM(0);
    }

    if (IN(1)) {
        pg8::Gemm g{XN, WIN, DM, DM, DM, 1 << 30, 0}; pg8::StaticOrder S; S.init(MTOK, INP, G, bx);
        pg8::EpiInProj E{PROJ, ssq_cq, ssq_ckv, swa_k_norm_g, mla_kr_norm_g, positions};
        pg8::gemm_phase<pg8::EpiInProj, pg8::StaticOrder>(lds, g, S, E);
        SEAM(1);
    }

    if (IN(3)) {
        pg8::Gemm g{PROJ + C_CQ, WUQKV, INP, 512, 512, 3, 512}; pg8::UpMemOrder S; S.init(MTOK, NQKV, G, bx, MEMN, WMEM);
        pg8::EpiUpProj E{QKVB, ssq_cq, ssq_ckv, KVMP, (LAS float*)(lds + MISC_OFF + 4096), mla_kn_norm_g};
        pg8::gemm_phase<pg8::EpiUpProj, pg8::UpMemOrder>(lds, g, S, E);
        SEAM(3);
    }


    if (IN(5)) {
        LAS unsigned* uq = (LAS unsigned*)(lds + MISC_OFF);
        unsigned pref = 0u; bool have_pref = false;
        const bool rank_first = (hi - lo > 1) && args.att_lo == 0 && G == N_MLA_UNITS && MISC[8 + 3] == 1u;
        const int qoff = rank_first ? N_MLA_UNITS : 0;
        bool first_static = rank_first;
        if (rank_first) { const unsigned i = MISC[8 + 2], j = bar.x & 7u; pref = (i >> 1) * 16u + j + 8u * (i & 1u); have_pref = true; }
        for (;;) {
            if (tid == 0) uq[0] = have_pref ? pref + (first_static ? 0u : (unsigned)qoff) : (unsigned)qoff + atomicAdd(ctl, 1u);
            first_static = false;
            __syncthreads();
            const int u = __builtin_amdgcn_readfirstlane((int)uq[0]) + args.att_lo;
            __syncthreads();
            if (u >= args.att_hi) break;
            have_pref = false;
            const int r32 = lane & 31;
            if (u < N_MLA_UNITS) {
                const int qb = 15 - (u >> 4), bh = u & 15, b = bh >> 2, h = bh & 3;
                const size_t tok0 = (size_t)b * SEQ + 256 * qb + 32 * wave;
                const int qabs = 256 * qb + 32 * wave + r32;
                attn_unit<128, 64, 128, 1>(lds, QKVB + tok0 * NQKV + h * 192, NQKV, QKVB + (size_t)b * SEQ * NQKV + 768 + h * 256, NQKV, PROJ + (size_t)b * SEQ * INP + C_KR, INP,
                                           QKVB + (size_t)b * SEQ * NQKV + 768 + h * 256 + 128, NQKV, Y + tok0 * DM + 1024 + h * 128, DM, 0, 4 * qb + 4,
                                           qabs, (256 * qb + 32 * wave + 31) >> 6, 0, 0.f, 0.f, positions[tok0 + r32], positions, false, mla_qn_norm_g, mla_qr_norm_g, ctl, pref); have_pref = true;
            } else if (u < N_MLA_UNITS + N_MEM_UNITS) {
                const int v = u - N_MLA_UNITS, qq = v & 3, bh = v >> 2, b = bh >> 2, h = bh & 3;
                kvm_finalize_bh(KVMP, KVM, mem_k_norm_g, b, h, tid);
                mem_unit(lds, PROJ, KVM, Y, mem_q_norm_g, b, h, qq, ctl, pref); have_pref = true;
            } else if (u >= N_ATT_UNITS) {
                LAS unsigned* scr = (LAS unsigned*)(lds + wave * 16384);
                int lane2 = lane; asm volatile("" : "+v"(lane2));
                int r = (u - N_ATT_UNITS) * 8 + wave;
                const float* W; bf16_t* WT; int K_, N_, mode; const float* ksc = nullptr;
                if (r < CV_OUT) { W = w_out; WT = WOUT; K_ = DM; N_ = DM; mode = 0; }
                else if ((r -= CV_OUT) < CV_G) { W = w_gate; WT = WGU; K_ = DM; N_ = DFF; mode = 1; ksc = ffn_norm_g; }
                else if ((r -= CV_G) < CV_G) { W = w_up; WT = WGU; K_ = DM; N_ = DFF; mode = 2; ksc = ffn_norm_g; }
                else { r -= CV_G; W = w_down; WT = WDN; K_ = DFF; N_ = DM; mode = 0; }
                p0_transpose_item(W, K_, N_, WT, mode, ksc, scr, r, lane2);
            } else {
                const int v = u - N_MLA_UNITS - N_MEM_UNITS, kvh = v & 1, n = (v >> 1) & 31, b = v >> 6;
                swa_unit(lds, PROJ, Y, positions, swa_q_norm_g, swa_sinks, b, n, kvh, ctl, pref); have_pref = true;
            }
        }
        SEAM(5);
    }

    if (IN(6)) {
        pg8::Gemm g{Y, WOUT, DM, DM, DM, 1 << 30, 0}; pg8::StaticOrder S; S.init(MTOK, DM, G, bx);
        pg8::EpiOutProj E{XN, xrms, ginv, HB, ssq};
        pg8::gemm_phase<pg8::EpiOutProj, pg8::StaticOrder>(lds, g, S, E);
        SEAM(6);
    }

    if (IN(7)) {
        pg8::Gemm g{HB, WGU, DM, DM, DM, 1 << 30, 0}; pg8::StaticOrder S; S.init(MTOK, 2 * DFF, G, bx);
        pg8::EpiSwiGLU E{ACT, ssq};
        pg8::gemm_phase<pg8::EpiSwiGLU, pg8::StaticOrder>(lds, g, S, E);
        SEAM(7);
    }

    if (IN(8)) {
        pg8::Gemm g{ACT, WDN, DFF, DFF, DFF, 1 << 30, 0}; pg8::StaticOrder S; S.init(MTOK, DM, G, bx, 1);
        pg8::EpiDown E{out, HB};
        pg8::gemm_phase<pg8::EpiDown, pg8::StaticOrder>(lds, g, S, E);
    }
#undef IN
#undef SEAM
}

extern "C" void kernel_launch(void* const* d_in, const int* in_sizes, int n_in, void* d_out, int out_size, void* d_ws, size_t ws_size, hipStream_t stream) {
    static int grid = 0;
    if (grid == 0) {
        if (n_in != 25 || out_size != MTOK * DM || ws_size < WS_END) { fprintf(stderr, "kernel_launch: unexpected shapes (n_in %d, out %d, ws %zu < %zu)\n", n_in, out_size, ws_size, (size_t)WS_END); grid = -1; return; }
        int dev = 0, cus = 0, per_cu = 0;
        hipGetDevice(&dev); hipDeviceGetAttribute(&cus, hipDeviceAttributeMultiprocessorCount, dev);
        if (hipFuncSetAttribute((const void*)fwd_kernel, hipFuncAttributeMaxDynamicSharedMemorySize, LDS_BYTES) != hipSuccess) { fprintf(stderr, "kernel_launch: hipFuncSetAttribute failed\n"); grid = -1; return; }
        if (hipOccupancyMaxActiveBlocksPerMultiprocessor(&per_cu, (const void*)fwd_kernel, 512, LDS_BYTES) != hipSuccess || per_cu < 1) { fprintf(stderr, "kernel_launch: occupancy query says %d\n", per_cu); per_cu = 1; }
        (void)hipGetLastError();
        grid = cus;
        if (grid < 32) grid = 32;
    }
    if (grid < 0) return;
    if (hipMemsetAsync((char*)d_ws + WS_CTL, 0, CTL_ZERO_BYTES, stream) != hipSuccess) { fprintf(stderr, "kernel_launch: hipMemsetAsync failed\n"); return; }
    Args a{};
    for (int i = 0; i < 25; ++i) a.in[i] = d_in[i];
    a.out = (float*)d_out; a.ws = (unsigned char*)d_ws; a.att_lo = 0; a.att_hi = N_QUEUE_UNITS;
#if N_LAUNCHES == 1
    a.lo = 0; a.hi = NPH;
    void* kargs[] = {&a};
    hipError_t e = hipLaunchCooperativeKernel((const void*)fwd_kernel, dim3(grid), dim3(512), kargs, LDS_BYTES, stream);
    if (e != hipSuccess) fprintf(stderr, "kernel_launch: cooperative launch failed: %s (grid %d)\n", hipGetErrorString(e), grid);
#else
    for (int p = 0; p < NPH; ++p) {
        a.lo = p; a.hi = p + 1;
        hipLaunchKernelGGL(fwd_kernel, dim3(grid), dim3(512), LDS_BYTES, stream, a);
#ifdef PROBE_REPEAT
        if (p == PROBE_REPEAT) { Args a2 = a;
#ifdef PROBE_ATT_LO
            a2.att_lo = PROBE_ATT_LO; a2.att_hi = PROBE_ATT_HI;
#endif
            for (int rep = 0; rep < PROBE_NREP; ++rep) { (void)hipMemsetAsync(d_ws, 0, 256, stream); hipLaunchKernelGGL(fwd_kernel, dim3(grid), dim3(512), LDS_BYTES, stream, a2); } }
#endif
    }
#endif
}
```
